# Optimizing an MI355X kernel written in HIP

```python
import math
import jax, jax.numpy as jnp
from jax import lax
import numpy as np

D_MODEL = 1024
BATCH = 8
SEQ = 2048
DEPTH = 2
DEC_BATCH = 128
DEC_SEQ = 1
PAST_LEN = 16384
PAGE_SIZE = 128

D_MIX = D_MODEL
BRANCH_W = D_MIX // 4
RET_HEADS = 4
RET_HEAD_DIM = BRANCH_W // RET_HEADS
HGRN_HEADS = 4
HGRN_HEAD_DIM = BRANCH_W // HGRN_HEADS
S5_CH_PER_GROUP = 16
S5_GROUPS = BRANCH_W // S5_CH_PER_GROUP
S5_STATE = 64
M2_HEAD_DIM = 64
M2_HEADS = BRANCH_W // M2_HEAD_DIM
M2_GROUPS = 2
M2_STATE = 64
M2_CONV = 4
M2_CONV_CH = BRANCH_W + 2 * M2_GROUPS * M2_STATE
CHUNK = 64
ROPE_BASE = 10000.0
EPS = 1e-6
EXP_CLIP = 60.0
PROJ_SIZES = (BRANCH_W, BRANCH_W, BRANCH_W, BRANCH_W,
              BRANCH_W, BRANCH_W, BRANCH_W, BRANCH_W,
              BRANCH_W, BRANCH_W,
              BRANCH_W, M2_CONV_CH, M2_HEADS)
PROJ_TOTAL = sum(PROJ_SIZES)

kernel_name = "hybrid_ret_hgrn2_s5_ssd_step"


def rms_norm(x, w):
    xf = x.astype(jnp.float32)
    y = xf * lax.rsqrt(jnp.mean(xf * xf, axis=-1, keepdims=True) + EPS)
    return (y * w.astype(jnp.float32)).astype(x.dtype)


def head_rms(o, w):
    o = o * lax.rsqrt(jnp.mean(o * o, axis=-1, keepdims=True) + EPS)
    return o.reshape(o.shape[:2] + (-1,)) * w.astype(jnp.float32)


def rotary(x, pos):
    half = x.shape[-1] // 2
    inv = 1.0 / (ROPE_BASE ** (jnp.arange(half, dtype=jnp.float32) / half))
    ang = pos[:, None] * inv[None, :]
    cos = jnp.cos(ang)[None, :, None, :]
    sin = jnp.sin(ang)[None, :, None, :]
    x1, x2 = x[..., :half], x[..., half:]
    return jnp.concatenate([x1 * cos - x2 * sin, x1 * sin + x2 * cos], axis=-1)


def chunked_linear_recurrence(q, k, v, log_a, h0, chunk):
    bsz, L, H, K = q.shape
    V = v.shape[-1]
    C = min(chunk, L)
    n = -(-L // C)
    pad = n * C - L
    per_channel = log_a.ndim == 4

    def prep(t):
        t = jnp.pad(t, [(0, 0), (0, pad)] + [(0, 0)] * (t.ndim - 2))
        return jnp.moveaxis(t.reshape((bsz, n, C) + t.shape[2:]), 1, 0)

    causal = jnp.tril(jnp.ones((C, C), dtype=bool))

    def masked_exp(diff, mask):
        return jnp.where(mask, jnp.exp(jnp.where(mask, diff, 0.0)), 0.0)

    def step(h, blk):
        qc, kc, vc, la = blk
        cum = jnp.cumsum(la, axis=1)
        total = cum[:, -1]
        diff = cum[:, :, None] - cum[:, None, :]
        if per_channel:
            o_inter = jnp.einsum('bchk,bhkv->bchv', qc * jnp.exp(cum), h)
            decay = masked_exp(diff, causal[None, :, :, None, None])
            scores = jnp.einsum('bthk,bshk,btshk->bhts', qc, kc, decay)
            k_end = kc * jnp.exp(total[:, None] - cum)
            h_new = jnp.exp(total)[..., None] * h + jnp.einsum('bshk,bshv->bhkv', k_end, vc)
        else:
            o_inter = jnp.einsum('bchk,bhkv->bchv', qc, h) * jnp.exp(cum)[..., None]
            decay = masked_exp(diff, causal[None, :, :, None])
            scores = jnp.einsum('bthk,bshk->bhts', qc, kc) * jnp.moveaxis(decay, 3, 1)
            k_end = kc * jnp.exp(total[:, None] - cum)[..., None]
            h_new = jnp.exp(total)[..., None, None] * h + jnp.einsum('bshk,bshv->bhkv', k_end, vc)
        o = o_inter + jnp.einsum('bhts,bshv->bthv', scores, vc)
        return h_new, o

    h_last, o = lax.scan(step, h0, (prep(q), prep(k), prep(v), prep(log_a)))
    o = jnp.moveaxis(o, 0, 1).reshape(bsz, n * C, H, V)[:, :L]
    return o, h_last


def s5_scan(u, h0_re, h0_im, A_re, A_im, log_dt, B_re, B_im, C_re, C_im):
    f32 = jnp.float32
    A_re, A_im = A_re.astype(f32), A_im.astype(f32)
    dt = jnp.exp(log_dt.astype(f32))[:, None]
    mag = jnp.exp(A_re * dt)
    ab_re, ab_im = mag * jnp.cos(A_im * dt), mag * jnp.sin(A_im * dt)
    nr, ni = ab_re - 1.0, ab_im
    den = A_re * A_re + A_im * A_im
    f_re = (nr * A_re + ni * A_im) / den
    f_im = (ni * A_re - nr * A_im) / den
    B_re, B_im = B_re.astype(f32), B_im.astype(f32)
    bb_re = f_re[..., None] * B_re - f_im[..., None] * B_im
    bb_im = f_re[..., None] * B_im + f_im[..., None] * B_re
    bu_re = jnp.einsum('blgc,gpc->blgp', u, bb_re)
    bu_im = jnp.einsum('blgc,gpc->blgp', u, bb_im)
    bu_re = bu_re.at[:, 0].add(ab_re * h0_re - ab_im * h0_im)
    bu_im = bu_im.at[:, 0].add(ab_re * h0_im + ab_im * h0_re)
    a_re = jnp.broadcast_to(ab_re, bu_re.shape)
    a_im = jnp.broadcast_to(ab_im, bu_im.shape)

    def combine(e1, e2):
        a1r, a1i, b1r, b1i = e1
        a2r, a2i, b2r, b2i = e2
        return (a2r * a1r - a2i * a1i, a2r * a1i + a2i * a1r,
                a2r * b1r - a2i * b1i + b2r, a2r * b1i + a2i * b1r + b2i)

    _, _, h_re, h_im = lax.associative_scan(combine, (a_re, a_im, bu_re, bu_im), axis=1)
    y = (jnp.einsum('blgp,gcp->blgc', h_re, C_re.astype(f32))
         - jnp.einsum('blgp,gcp->blgc', h_im, C_im.astype(f32)))
    return y, h_re[:, -1], h_im[:, -1]


def causal_conv(xbc, buf, w, b):
    L = xbc.shape[1]
    full = jnp.concatenate([buf, xbc], axis=1)
    out = b.astype(jnp.float32) + sum(full[:, i:i + L] * w[i].astype(jnp.float32)
                                      for i in range(M2_CONV))
    return jax.nn.silu(out), full[:, -(M2_CONV - 1):]


def hybrid_layer(x, pos0, ret_h0, hgrn_h0, s5_h0_re, s5_h0_im, m2_h0, m2_buf0, lb,
                 norm_w, w_in, ret_norm_w, hgrn_norm_w,
                 s5_A_re, s5_A_im, s5_log_dt, s5_B_re, s5_B_im, s5_C_re, s5_C_im,
                 s5_D, s5_glu_w, s5_glu_b,
                 m2_conv_w, m2_conv_b, m2_dt_bias, m2_A_log, m2_D, m2_norm_w, w_out):
    f32 = jnp.float32
    bsz, L, _ = x.shape
    hn = rms_norm(x, norm_w)
    proj = (hn @ w_in).astype(f32)
    points = np.cumsum(PROJ_SIZES)[:-1].tolist()
    (r_q, r_k, r_v, r_g, g_q, g_f, g_i, g_g, s_u, s_g, m_z, m_xbc, m_dt) = jnp.split(proj, points, axis=-1)

    pos = pos0 + jnp.arange(L, dtype=f32)
    rq = rotary(r_q.reshape(bsz, L, RET_HEADS, RET_HEAD_DIM), pos)
    rk = rotary(r_k.reshape(bsz, L, RET_HEADS, RET_HEAD_DIM), pos) * (RET_HEAD_DIM ** -0.5)
    rv = r_v.reshape(bsz, L, RET_HEADS, RET_HEAD_DIM)
    log_gamma = jnp.log1p(-(2.0 ** (-5.0 - jnp.arange(RET_HEADS, dtype=f32))))
    r_la = jnp.broadcast_to(log_gamma, (bsz, L, RET_HEADS))
    r_o, ret_h = chunked_linear_recurrence(rq, rk, rv, r_la, ret_h0.astype(f32), CHUNK)
    o_ret = head_rms(r_o, ret_norm_w) * jax.nn.silu(r_g)

    hq = jax.nn.silu(g_q).reshape(bsz, L, HGRN_HEADS, HGRN_HEAD_DIM)
    fr = g_f.reshape(bsz, L, HGRN_HEADS, HGRN_HEAD_DIM)
    lb_h = lb.reshape(HGRN_HEADS, HGRN_HEAD_DIM)
    log_f = jax.nn.log_sigmoid(fr) + jnp.log1p(lb_h * jnp.exp(jnp.minimum(-fr, EXP_CLIP)))
    hk = (1.0 - lb_h) * jax.nn.sigmoid(-fr)
    hv = g_i.reshape(bsz, L, HGRN_HEADS, HGRN_HEAD_DIM)
    h_o, hgrn_h = chunked_linear_recurrence(hq, hk, hv, log_f, hgrn_h0.astype(f32), CHUNK)
    o_hgrn = head_rms(h_o, hgrn_norm_w) * jax.nn.silu(g_g)

    u = s_u.reshape(bsz, L, S5_GROUPS, S5_CH_PER_GROUP)
    sy, s5_re, s5_im = s5_scan(u, s5_h0_re.astype(f32), s5_h0_im.astype(f32), s5_A_re, s5_A_im,
                               s5_log_dt, s5_B_re, s5_B_im, s5_C_re, s5_C_im)
    sy = sy + s5_D.astype(f32).reshape(S5_GROUPS, S5_CH_PER_GROUP) * u
    gy = jax.nn.gelu(sy.reshape(bsz, L, BRANCH_W))
    o_s5 = gy * jax.nn.sigmoid(gy @ s5_glu_w.astype(f32) + s5_glu_b.astype(f32)) * jax.nn.silu(s_g)

    xbc, m2_buf = causal_conv(m_xbc, m2_buf0.astype(f32), m2_conv_w, m2_conv_b)
    gn = M2_GROUPS * M2_STATE
    xm = xbc[..., :BRANCH_W].reshape(bsz, L, M2_HEADS, M2_HEAD_DIM)
    Bm = jnp.repeat(xbc[..., BRANCH_W:BRANCH_W + gn].reshape(bsz, L, M2_GROUPS, M2_STATE),
                    M2_HEADS // M2_GROUPS, axis=2)
    Cm = jnp.repeat(xbc[..., BRANCH_W + gn:].reshape(bsz, L, M2_GROUPS, M2_STATE),
                    M2_HEADS // M2_GROUPS, axis=2)
    dt = jax.nn.softplus(m_dt + m2_dt_bias.astype(f32))
    A = -jnp.exp(m2_A_log.astype(f32))
    m_o, m2_h = chunked_linear_recurrence(Cm, Bm, xm * dt[..., None], dt * A,
                                          m2_h0.astype(f32), CHUNK)
    my = (m_o + m2_D.astype(f32)[:, None] * xm).reshape(bsz, L, BRANCH_W) * jax.nn.silu(m_z)
    o_m2 = my * lax.rsqrt(jnp.mean(my * my, axis=-1, keepdims=True) + EPS) * m2_norm_w.astype(f32)

    mixed = jnp.concatenate([o_ret, o_hgrn, o_s5, o_m2], axis=-1).astype(x.dtype)
    x_out = x + mixed @ w_out
    return x_out, (ret_h, hgrn_h, s5_re, s5_im, m2_h, m2_buf)


def setup_inputs(seed: int = 0) -> dict:
    key = jax.random.key(seed)
    ks = iter(jax.random.split(key, 48))
    f32 = jnp.float32

    def nrm(shape, s):
        return s * jax.random.normal(next(ks), shape, f32)

    def unif(shape, lo, hi):
        return jax.random.uniform(next(ks), shape, f32, lo, hi)

    inp = {}
    inp["x_prompt"] = nrm((BATCH, SEQ, D_MODEL), 1.0)
    inp["x_sample"] = nrm((DEC_BATCH, DEC_SEQ, D_MODEL), 1.0)
    inp["state_ret"] = nrm((DEPTH, DEC_BATCH, RET_HEADS, RET_HEAD_DIM, RET_HEAD_DIM), 0.3)
    inp["state_hgrn"] = nrm((DEPTH, DEC_BATCH, HGRN_HEADS, HGRN_HEAD_DIM, HGRN_HEAD_DIM), 0.5)
    inp["state_s5_re"] = nrm((DEPTH, DEC_BATCH, S5_GROUPS, S5_STATE), 0.1)
    inp["state_s5_im"] = nrm((DEPTH, DEC_BATCH, S5_GROUPS, S5_STATE), 0.1)
    inp["state_m2_ssm"] = nrm((DEPTH, DEC_BATCH, M2_HEADS, M2_STATE, M2_HEAD_DIM), 0.3)
    inp["state_m2_conv"] = nrm((DEPTH, DEC_BATCH, M2_CONV - 1, M2_CONV_CH), 1.0)
    inp["norm_w"] = 1.0 + nrm((DEPTH, D_MODEL), 0.01)
    inp["w_in"] = nrm((DEPTH, D_MODEL, PROJ_TOTAL), D_MODEL ** -0.5)
    inp["ret_norm_w"] = 1.0 + nrm((DEPTH, BRANCH_W), 0.01)
    inp["hgrn_lb_logits"] = 1.0 + nrm((DEPTH, BRANCH_W), 0.1)
    inp["hgrn_norm_w"] = 1.0 + nrm((DEPTH, BRANCH_W), 0.01)
    inp["s5_A_re"] = -0.5 + nrm((DEPTH, S5_GROUPS, S5_STATE), 0.01)
    inp["s5_A_im"] = jnp.pi * jnp.arange(S5_STATE, dtype=f32) + nrm((DEPTH, S5_GROUPS, S5_STATE), 0.01)
    inp["s5_log_dt"] = unif((DEPTH, S5_GROUPS), math.log(1e-3), math.log(1e-1))
    inp["s5_B_re"] = nrm((DEPTH, S5_GROUPS, S5_STATE, S5_CH_PER_GROUP), (2 * S5_CH_PER_GROUP) ** -0.5)
    inp["s5_B_im"] = nrm((DEPTH, S5_GROUPS, S5_STATE, S5_CH_PER_GROUP), (2 * S5_CH_PER_GROUP) ** -0.5)
    inp["s5_C_re"] = nrm((DEPTH, S5_GROUPS, S5_CH_PER_GROUP, S5_STATE), (2 * S5_STATE) ** -0.5)
    inp["s5_C_im"] = nrm((DEPTH, S5_GROUPS, S5_CH_PER_GROUP, S5_STATE), (2 * S5_STATE) ** -0.5)
    inp["s5_D"] = nrm((DEPTH, BRANCH_W), 1.0)
    inp["s5_glu_w"] = nrm((DEPTH, BRANCH_W, BRANCH_W), BRANCH_W ** -0.5)
    inp["s5_glu_b"] = nrm((DEPTH, BRANCH_W), 0.01)
    inp["m2_conv_w"] = nrm((DEPTH, M2_CONV, M2_CONV_CH), M2_CONV ** -0.5)
    inp["m2_conv_b"] = nrm((DEPTH, M2_CONV_CH), 0.01)
    dt0 = jnp.exp(unif((DEPTH, M2_HEADS), math.log(1e-3), math.log(1e-1)))
    inp["m2_dt_bias"] = dt0 + jnp.log(-jnp.expm1(-dt0))
    inp["m2_A_log"] = jnp.log(unif((DEPTH, M2_HEADS), 1.0, 16.0))
    inp["m2_D"] = 1.0 + nrm((DEPTH, M2_HEADS), 0.1)
    inp["m2_norm_w"] = 1.0 + nrm((DEPTH, BRANCH_W), 0.01)
    inp["w_out"] = nrm((DEPTH, D_MIX, D_MODEL), 0.5 * D_MIX ** -0.5)
    inp["final_norm_w"] = 1.0 + nrm((D_MODEL,), 0.01)
    return inp


def reference(x_prompt, x_sample, state_ret, state_hgrn, state_s5_re, state_s5_im,
              state_m2_ssm, state_m2_conv, norm_w, w_in, ret_norm_w, hgrn_lb_logits,
              hgrn_norm_w, s5_A_re, s5_A_im, s5_log_dt, s5_B_re, s5_B_im, s5_C_re,
              s5_C_im, s5_D, s5_glu_w, s5_glu_b, m2_conv_w, m2_conv_b, m2_dt_bias,
              m2_A_log, m2_D, m2_norm_w, w_out, final_norm_w):
    f32 = jnp.float32
    lb_sm = jax.nn.softmax(hgrn_lb_logits.astype(f32), axis=0)
    lb_all = jnp.clip(jnp.cumsum(lb_sm, axis=0) - lb_sm[0], 0.0, 1.0)

    def zero_states(b):
        return (jnp.zeros((b, RET_HEADS, RET_HEAD_DIM, RET_HEAD_DIM), f32),
                jnp.zeros((b, HGRN_HEADS, HGRN_HEAD_DIM, HGRN_HEAD_DIM), f32),
                jnp.zeros((b, S5_GROUPS, S5_STATE), f32),
                jnp.zeros((b, S5_GROUPS, S5_STATE), f32),
                jnp.zeros((b, M2_HEADS, M2_STATE, M2_HEAD_DIM), f32),
                jnp.zeros((b, M2_CONV - 1, M2_CONV_CH), f32))

    xp, xs = x_prompt, x_sample
    new_p, new_s = [], []
    for l in range(DEPTH):
        lw = (norm_w[l], w_in[l], ret_norm_w[l], hgrn_norm_w[l],
              s5_A_re[l], s5_A_im[l], s5_log_dt[l], s5_B_re[l], s5_B_im[l], s5_C_re[l],
              s5_C_im[l], s5_D[l], s5_glu_w[l], s5_glu_b[l],
              m2_conv_w[l], m2_conv_b[l], m2_dt_bias[l], m2_A_log[l], m2_D[l], m2_norm_w[l],
              w_out[l])
        xp, sp = hybrid_layer(xp, 0, *zero_states(xp.shape[0]), lb_all[l], *lw)
        xs, ss = hybrid_layer(xs, PAST_LEN, state_ret[l], state_hgrn[l], state_s5_re[l],
                              state_s5_im[l], state_m2_ssm[l], state_m2_conv[l], lb_all[l], *lw)
        new_p.append(sp)
        new_s.append(ss)

    y_prompt = rms_norm(xp, final_norm_w)
    y_sample = rms_norm(xs, final_norm_w)
    stk = lambda lst, i: jnp.stack([s[i] for s in lst], axis=0)
    return (y_prompt, y_sample,
            stk(new_p, 0), stk(new_p, 1), stk(new_p, 2), stk(new_p, 3), stk(new_p, 4), stk(new_p, 5),
            stk(new_s, 0), stk(new_s, 1), stk(new_s, 2), stk(new_s, 3), stk(new_s, 4), stk(new_s, 5))
```

```cpp
#include <hip/hip_runtime.h>
#include <cstdio>
#include <cstdint>
namespace pg8 {
#define PG8_LAS __attribute__((address_space(3)))
typedef unsigned short bf16_t;
typedef short bf16x8 __attribute__((ext_vector_type(8)));
typedef float f32x4 __attribute__((ext_vector_type(4)));
typedef unsigned u32x4 __attribute__((ext_vector_type(4)));
constexpr int BM = 256, BK = 64, HALF = 128, HTB = HALF * BK * 2  , STAGE_BYTES = 8 * HTB, NXCD = 8, WGM = 8;

__host__ __device__ __forceinline__ int lds_byte(int r, int c) { const int st = (r >> 4) * 2 + (c >> 5), rr = r & 15, cc = c & 31, ob = rr * 64 + cc * 2; return st * 1024 + (ob ^ (((ob >> 9) & 1) << 5)); }
__host__ __device__ __forceinline__ void stage_rc(int b, int& R, int& C) { const int st = b / 1024, sb = b % 1024, swz = sb ^ (((sb >> 9) & 1) << 5); R = (st >> 1) * 16 + swz / 64; C = (st & 1) * 32 + (swz % 64) / 2; }
__host__ __device__ __forceinline__ int perm32(int rho) { const int n = rho >> 4, i = rho & 15; return 8 * (i >> 2) + 4 * n + (i & 3); }

struct Unit { int pm, pn; };
struct Gemm { const bf16_t* A; const bf16_t* Bt; int M, N, K; };

struct StaticOrder {
    int nM, nN, nwg, G, c;
    __host__ __device__ void init(int M, int N, int G_, int c_) { nM = M / BM; nN = N / BM; nwg = nM * nN; G = G_; c = c_; }
    __host__ __device__ bool next(int i, Unit& u) const {
        const long L = (long)i * G + c; if (L >= nwg) return false;
        int wgid = (int)L; { const int q = nwg / NXCD, r = nwg % NXCD, xcd = wgid % NXCD, off = wgid / NXCD; wgid = (xcd < r ? xcd * (q + 1) : r * (q + 1) + (xcd - r) * q) + off; }
        const int nig = WGM * nN, gid = wgid / nig, fm = gid * WGM, gsz = (nM - fm) < WGM ? (nM - fm) : WGM;
        u.pm = fm + ((wgid % nig) % gsz); u.pn = (wgid % nig) / gsz; return true;
    }
    __device__ __forceinline__ void a_ready(const Unit&) const {}
    __device__ __forceinline__ void done(const Unit&) const {}
};

__device__ __forceinline__ unsigned cvt_pk_bf16(float lo, float hi) { unsigned r; asm volatile("v_cvt_pk_bf16_f32 %0, %1, %2" : "=v"(r) : "v"(lo), "v"(hi)); return r; }
typedef float f32x2 __attribute__((ext_vector_type(2)));
__device__ __forceinline__ f32x2 gelu_pk(f32x2 v) {
    const f32x2 av = __builtin_elementwise_abs(v), d = av * 0.2316418882f + 1.0f;
    f32x2 t; t.x = __builtin_amdgcn_rcpf(d.x); t.y = __builtin_amdgcn_rcpf(d.y);
    f32x2 q = t * 0.5307027145f + (-0.7265760135f); q = q * t + 0.7107068705f; q = q * t + (-0.142248368f); q = q * t + 0.127414796f; q = q * t;
    const f32x2 s = (v * v) * (-0.72134752044f);
    f32x2 e; e.x = __builtin_amdgcn_exp2f(s.x); e.y = __builtin_amdgcn_exp2f(s.y);
    const f32x2 m = v * (q * e), r = v - m;
    f32x2 o; o.x = v.x < 0.f ? m.x : r.x; o.y = v.y < 0.f ? m.y : r.y; return o;
}

template <int ACT  > struct EpiBf16 {
    static constexpr bool PERM = true, AFTER_DRAIN = false; static_assert(ACT == 0 || ACT == 1, "EpiBf16: ACT is 0 (none) or 1 (gelu_pk)");
    bf16_t* O; int ldc; const float* bias; int split_cols; size_t split_stride; float scale0;
    __device__ __forceinline__ void operator()(const f32x4 (&acc)[2][2][4][2], const Unit& u, int wr, int wc, int fr, int fq) const {
        const int row0 = u.pm * BM + wr * 64 + fr; int colt = u.pn * BM; bf16_t* base = O;
        float sc = 1.f; if (split_cols) { const int t = colt / split_cols; base += (size_t)t * split_stride; colt -= t * split_cols; if (t == 0) sc = scale0; }
        const int col0 = colt + wc * 32 + 8 * fq, bcol0 = u.pn * BM + wc * 32 + 8 * fq;
        f32x4 bv[2][2];
#pragma unroll
        for (int bj = 0; bj < 2; ++bj)
#pragma unroll
            for (int n = 0; n < 2; ++n) bv[bj][n] = bias ? *(const f32x4*)(bias + bcol0 + bj * HALF + 4 * n) : (f32x4){0.f, 0.f, 0.f, 0.f};
#pragma unroll
        for (int ai = 0; ai < 2; ++ai)
#pragma unroll
            for (int m = 0; m < 4; ++m) { bf16_t* rowp = base + (size_t)(row0 + ai * HALF + m * 16) * ldc + col0;
#pragma unroll
                for (int bj = 0; bj < 2; ++bj) { f32x4 v0 = acc[ai][bj][m][0] + bv[bj][0], v1 = acc[ai][bj][m][1] + bv[bj][1];
                    if (ACT == 1) { f32x2 a = gelu_pk((f32x2){v0[0], v0[1]}), b = gelu_pk((f32x2){v0[2], v0[3]}), c = gelu_pk((f32x2){v1[0], v1[1]}), d = gelu_pk((f32x2){v1[2], v1[3]});
                        v0 = (f32x4){a.x, a.y, b.x, b.y}; v1 = (f32x4){c.x, c.y, d.x, d.y}; }
                    v0 = v0 * sc; v1 = v1 * sc; u32x4 w; w.x = cvt_pk_bf16(v0[0], v0[1]); w.y = cvt_pk_bf16(v0[2], v0[3]); w.z = cvt_pk_bf16(v1[0], v1[1]); w.w = cvt_pk_bf16(v1[2], v1[3]);
                    *(u32x4*)(rowp + bj * HALF) = w; } }
    }
};

__device__ __forceinline__ float bf2f(unsigned short b) { return __uint_as_float((unsigned)b << 16); }
__device__ __forceinline__ float ex2(float x) { return __builtin_amdgcn_exp2f(x); }
__device__ __forceinline__ float fexp(float x) { return __builtin_amdgcn_exp2f(x * 1.4426950408889634f); }
__device__ __forceinline__ float sigm(float x) { return 1.f / (1.f + fexp(-x)); }
__device__ __forceinline__ float silu(float x) { return x / (1.f + fexp(-x)); }
struct EpiResid {
    static constexpr bool PERM = false, AFTER_DRAIN = false;
    const float* xp; const float* xs; float* out; int layer0;
    __device__ __forceinline__ void operator()(const f32x4 (&acc)[2][2][4][2], const Unit& u, int wr, int wc, int fr, int fq) const {
        const int row0 = u.pm * BM + wr * 64 + fr, col0 = u.pn * BM + wc * 32 + 4 * fq;
#pragma unroll
        for (int ai = 0; ai < 2; ++ai)
#pragma unroll
            for (int m = 0; m < 4; ++m) { const int row = row0 + ai * HALF + m * 16;
                if (row < 16512) {
                    const float* src = layer0 ? (row < 16384 ? xp + (size_t)row * 1024 : xs + (size_t)(row - 16384) * 1024) : out + (size_t)row * 1024;
                    float* dst = out + (size_t)row * 1024;
#pragma unroll
                    for (int bj = 0; bj < 2; ++bj)
#pragma unroll
                        for (int n = 0; n < 2; ++n) { const int c = col0 + bj * HALF + n * 16; *(f32x4*)(dst + c) = *(const f32x4*)(src + c) + acc[ai][bj][m][n]; }
                }
                asm volatile("" ::: "memory"); }
    }
};
struct EpiGlu {
    static constexpr bool PERM = true, AFTER_DRAIN = false;
    const bf16_t* GY; const bf16_t* PROJ; bf16_t* MIXED; const float* bias;
    __device__ __forceinline__ void operator()(const f32x4 (&acc)[2][2][4][2], const Unit& u, int wr, int wc, int fr, int fq) const {
        const unsigned row0 = u.pm * BM + wr * 64 + fr, col0 = wc * 32 + 8 * fq;
        const char* gyb = (const char*)GY; const char* pjb = (const char*)PROJ; char* mxb = (char*)MIXED;
#pragma unroll
        for (int bj = 0; bj < 2; ++bj) { const unsigned c = col0 + bj * HALF;
            const f32x4 b0 = *(const f32x4*)(bias + c), b1 = *(const f32x4*)(bias + c + 4);
#pragma unroll
            for (int ai = 0; ai < 2; ++ai)
#pragma unroll
                for (int m = 0; m < 4; ++m) { const unsigned row = row0 + ai * HALF + m * 16;
                    const f32x4 z0 = acc[ai][bj][m][0] + b0, z1 = acc[ai][bj][m][1] + b1;
                    const u32x4 g = *(const u32x4*)(gyb + (row * 256u + c) * 2u), s = *(const u32x4*)(pjb + (row * 3328u + 2304u + c) * 2u);
                    float o[8];
#pragma unroll
                    for (int i = 0; i < 4; ++i) {
                        const float gl = __uint_as_float(g[i] << 16), gh = __uint_as_float(g[i] & 0xffff0000u), sl = __uint_as_float(s[i] << 16), sh = __uint_as_float(s[i] & 0xffff0000u);
                        const float zl = (2 * i < 4) ? z0[(2 * i) & 3] : z1[(2 * i) & 3], zh = (2 * i + 1 < 4) ? z0[(2 * i + 1) & 3] : z1[(2 * i + 1) & 3];
                        o[2 * i] = gl * sigm(zl) * silu(sl); o[2 * i + 1] = gh * sigm(zh) * silu(sh); }
                    u32x4 w; w.x = cvt_pk_bf16(o[0], o[1]); w.y = cvt_pk_bf16(o[2], o[3]); w.z = cvt_pk_bf16(o[4], o[5]); w.w = cvt_pk_bf16(o[6], o[7]);
                    *(u32x4*)(mxb + (row * 1024u + 512u + c) * 2u) = w;
                    asm volatile("" ::: "memory"); } }
    }
};
template <class Epi, class Sched, bool ALIGN_EPI = false, bool SP2 = false>
__device__ __forceinline__ void gemm_phase(PG8_LAS unsigned char* lds, const Gemm g, const Sched& S, const Epi& E, const int tid) {
    const int wid = __builtin_amdgcn_readfirstlane(tid >> 6), lane = tid & 63, wr = wid >> 2, wc = wid & 3, fr = lane & 15, fq = lane >> 4;
    const int K = g.K, nt = K / BK;
    unsigned voffA[2], voffB[2];
#pragma unroll
    for (int i = 0; i < 2; ++i) { int R, C; stage_rc(tid * 16 + i * 8192, R, C); const int Rb = Epi::PERM ? ((R & ~31) + perm32(R & 31)) : R;
        voffA[i] = (unsigned)(R * K + C) * 2u; voffB[i] = (unsigned)(Rb * K + C) * 2u; }
    const size_t kstep = (size_t)(BK * 2);
    const size_t hstep = (size_t)HALF * K * 2;
    const size_t tstep = 2 * hstep;
    const unsigned ldsw = (unsigned)wid * 1024u;
    const int aoff = lds_byte(wr * 64 + fr, fq * 8), boff = lds_byte(wc * 32 + fr, fq * 8);
#define PG8_SA(b, h) (((b) * 2 + (h)) * HTB)
#define PG8_SB(b, h) ((4 + (b) * 2 + (h)) * HTB)
#define PG8_STAGE(bufoff, gbase, voff) do { _Pragma("unroll") for (int _i = 0; _i < 2; ++_i) \
        __builtin_amdgcn_global_load_lds((const unsigned*)((const char*)(gbase) + (voff)[_i]), (PG8_LAS unsigned*)(lds + (bufoff) + ldsw + _i * 8192), 16, 0, 0); } while (0)
#define PG8_LDA(dst, b, h) do { _Pragma("unroll") for (int m = 0; m < 4; ++m) _Pragma("unroll") for (int k = 0; k < 2; ++k) dst[m][k] = *(const PG8_LAS bf16x8*)(lds + PG8_SA(b, h) + aoff + m * 2048 + k * 1024); } while (0)
#define PG8_LDB(dst, b, h) do { _Pragma("unroll") for (int n = 0; n < 2; ++n) _Pragma("unroll") for (int k = 0; k < 2; ++k) dst[n][k] = *(const PG8_LAS bf16x8*)(lds + PG8_SB(b, h) + boff + n * 2048 + k * 1024); } while (0)
#define PG8_MMA(ai, bj, At, Bt) do { __builtin_amdgcn_s_setprio(1); _Pragma("unroll") for (int m = 0; m < 4; ++m) _Pragma("unroll") for (int n = 0; n < 2; ++n) _Pragma("unroll") for (int k = 0; k < 2; ++k) \
        acc[ai][bj][m][n] = __builtin_amdgcn_mfma_f32_16x16x32_bf16(Bt[n][k], At[m][k], acc[ai][bj][m][n], 0, 0, 0); __builtin_amdgcn_s_setprio(0); } while (0)
#define PG8_WAIT_V(n) asm volatile("s_waitcnt vmcnt(" #n ")" ::: "memory")
#define PG8_WAIT_L(n) asm volatile("s_waitcnt lgkmcnt(" #n ")" ::: "memory")
#define PG8_BAR __builtin_amdgcn_s_barrier()
#define PG8_SCHED __builtin_amdgcn_sched_barrier(0)
    Unit cur, nxt; int ui = 0;
    if (!S.next(0, cur)) return;
    f32x4 acc[2][2][4][2];
#pragma unroll
    for (int a = 0; a < 2; ++a)
#pragma unroll
        for (int b = 0; b < 2; ++b)
#pragma unroll
            for (int m = 0; m < 4; ++m)
#pragma unroll
                for (int n = 0; n < 2; ++n) acc[a][b][m][n] = (f32x4){0.f, 0.f, 0.f, 0.f};
    bf16x8 At[4][2], B0[2][2], B1[2][2];
    const char* cA = (const char*)g.A + (size_t)cur.pm * tstep; const char* cB = (const char*)g.Bt + (size_t)cur.pn * tstep;
    S.a_ready(cur);
    if constexpr (SP2) {
        PG8_STAGE(PG8_SB(0, 0), cB, voffB); PG8_STAGE(PG8_SB(0, 1), cB + hstep, voffB); PG8_STAGE(PG8_SA(0, 0), cA, voffA); PG8_STAGE(PG8_SA(0, 1), cA + hstep, voffA);
        if (wr == 1) PG8_BAR;
        PG8_WAIT_V(2); PG8_BAR;
        PG8_STAGE(PG8_SB(1, 0), cB + kstep, voffB); PG8_STAGE(PG8_SA(1, 0), cA + kstep, voffA); PG8_STAGE(PG8_SB(1, 1), cB + hstep + kstep, voffB);
        PG8_WAIT_V(6); PG8_BAR;
    } else {
        PG8_STAGE(PG8_SB(0, 0), cB, voffB); PG8_STAGE(PG8_SA(0, 0), cA, voffA); PG8_STAGE(PG8_SB(0, 1), cB + hstep, voffB); PG8_STAGE(PG8_SA(0, 1), cA + hstep, voffA);
        if (wr == 1) PG8_BAR;
        PG8_WAIT_V(4); PG8_BAR;
        PG8_STAGE(PG8_SB(1, 0), cB + kstep, voffB); PG8_STAGE(PG8_SA(1, 0), cA + kstep, voffA); PG8_STAGE(PG8_SB(1, 1), cB + hstep + kstep, voffB);
        PG8_WAIT_V(6); PG8_BAR;
    }
    for (;;) {
        const bool has_next = S.next(ui + 1, nxt);
        const char* nA = has_next ? (const char*)g.A + (size_t)nxt.pm * tstep : cA; const char* nB = has_next ? (const char*)g.Bt + (size_t)nxt.pn * tstep : cB;
        for (int t = 0; t < nt; t += 2) {
            const bool last = (t == nt - 2);
            const char* a1 = cA + (size_t)(t + 1) * kstep;
            const char* a2 = last ? nA : cA + (size_t)(t + 2) * kstep; const char* b2 = last ? nB : cB + (size_t)(t + 2) * kstep;
            const char* a3 = a2 + kstep; const char* b3 = b2 + kstep;
            if (last && has_next) S.a_ready(nxt);
            if constexpr (SP2) {
            PG8_LDB(B0, 0, 0); PG8_LDB(B1, 0, 1); PG8_SCHED; PG8_LDA(At, 0, 0); PG8_STAGE(PG8_SA(1, 1), a1 + hstep, voffA);
            PG8_WAIT_V(8); PG8_WAIT_L(0); PG8_BAR; PG8_MMA(0, 0, At, B0); PG8_MMA(0, 1, At, B1); PG8_BAR; PG8_SCHED;
            PG8_LDA(At, 0, 1); PG8_STAGE(PG8_SB(0, 0), b2, voffB); PG8_STAGE(PG8_SB(0, 1), b2 + hstep, voffB); PG8_STAGE(PG8_SA(0, 0), a2, voffA);
            PG8_WAIT_V(8); PG8_WAIT_L(0); PG8_BAR; PG8_MMA(1, 0, At, B0); PG8_MMA(1, 1, At, B1); PG8_BAR; PG8_SCHED;
            PG8_LDB(B0, 1, 0); PG8_LDB(B1, 1, 1); PG8_SCHED; PG8_LDA(At, 1, 0); PG8_STAGE(PG8_SA(0, 1), a2 + hstep, voffA);
            PG8_WAIT_V(8); PG8_WAIT_L(0); PG8_BAR; PG8_MMA(0, 0, At, B0); PG8_MMA(0, 1, At, B1); PG8_BAR; PG8_SCHED;
            PG8_LDA(At, 1, 1); PG8_STAGE(PG8_SB(1, 0), b3, voffB); PG8_STAGE(PG8_SB(1, 1), b3 + hstep, voffB); PG8_STAGE(PG8_SA(1, 0), a3, voffA);
            PG8_WAIT_V(8); PG8_WAIT_L(0); PG8_BAR; PG8_MMA(1, 0, At, B0); PG8_MMA(1, 1, At, B1); PG8_BAR; PG8_SCHED;
            } else {
            PG8_LDB(B0, 0, 0); PG8_SCHED; PG8_LDA(At, 0, 0); PG8_STAGE(PG8_SA(1, 1), a1 + hstep, voffA);
            PG8_WAIT_L(8); PG8_BAR; PG8_WAIT_L(0); PG8_MMA(0, 0, At, B0); PG8_BAR; PG8_SCHED;
            PG8_LDB(B1, 0, 1); PG8_STAGE(PG8_SB(0, 0), b2, voffB);
            PG8_BAR; PG8_WAIT_L(0); PG8_MMA(0, 1, At, B1); PG8_BAR;
            PG8_LDA(At, 0, 1); PG8_STAGE(PG8_SA(0, 0), a2, voffA);
            PG8_BAR; PG8_WAIT_L(0); PG8_MMA(1, 0, At, B0); PG8_BAR; PG8_SCHED;
            PG8_STAGE(PG8_SB(0, 1), b2 + hstep, voffB);
            PG8_WAIT_V(6); PG8_BAR; PG8_MMA(1, 1, At, B1); PG8_BAR;
            PG8_LDB(B0, 1, 0); PG8_SCHED; PG8_LDA(At, 1, 0); PG8_STAGE(PG8_SA(0, 1), a2 + hstep, voffA);
            PG8_WAIT_L(8); PG8_BAR; PG8_WAIT_L(0); PG8_MMA(0, 0, At, B0); PG8_BAR; PG8_SCHED;
            PG8_LDB(B1, 1, 1); PG8_STAGE(PG8_SB(1, 0), b3, voffB);
            PG8_BAR; PG8_WAIT_L(0); PG8_MMA(0, 1, At, B1); PG8_BAR;
            PG8_LDA(At, 1, 1); PG8_STAGE(PG8_SA(1, 0), a3, voffA);
            PG8_BAR; PG8_WAIT_L(0); PG8_MMA(1, 0, At, B0); PG8_BAR; PG8_SCHED;
            PG8_STAGE(PG8_SB(1, 1), b3 + hstep, voffB);
            PG8_WAIT_V(6); PG8_BAR; PG8_MMA(1, 1, At, B1); PG8_BAR;
            }
        }
        if constexpr (ALIGN_EPI) { if (wr == 0) PG8_BAR; }
        if constexpr (!Epi::AFTER_DRAIN) { E(acc, cur, wr, wc, fr, fq); S.done(cur); }
        if (!has_next) break;
#pragma unroll
        for (int a = 0; a < 2; ++a)
#pragma unroll
            for (int b = 0; b < 2; ++b)
#pragma unroll
                for (int m = 0; m < 4; ++m)
#pragma unroll
                    for (int n = 0; n < 2; ++n) acc[a][b][m][n] = (f32x4){0.f, 0.f, 0.f, 0.f};
        cur = nxt; cA = nA; cB = nB; ++ui;
        if constexpr (ALIGN_EPI) { if (wr == 1) PG8_BAR; }
    }
    PG8_WAIT_V(0);
    if constexpr (!ALIGN_EPI) { if (wr == 0) PG8_BAR; }
    PG8_BAR;
    if constexpr (Epi::AFTER_DRAIN) { E.fused(acc, cur, wr, wc, fr, fq, lds, wid, lane); S.done(cur); }
#undef PG8_SA
#undef PG8_SB
#undef PG8_STAGE
#undef PG8_LDA
#undef PG8_LDB
#undef PG8_MMA
#undef PG8_WAIT_V
#undef PG8_WAIT_L
#undef PG8_BAR
#undef PG8_SCHED
}
}

constexpr int NWAVES = 8, NTHR = 512;
#ifndef MK_N_LAUNCHES
#define MK_N_LAUNCHES 1
#endif
constexpr int N_PHASES = 13;
constexpr int DM = 1024, MPROMPT = 16384, MSAMP = 128, MVALID = 16512, MPAD = 16640, SEQL = 2048, NB = 8;
constexpr int NPROJ = 3328, NPROJ_FULL = 3332;
constexpr float EPS = 1e-6f;
constexpr size_t O_Y = 0, O_PRET = 16908288, O_PHGRN = 17170432, O_PS5R = 17432576, O_PS5I = 17448960, O_PM2 = 17465344, O_PCONV = 17727488,
                 O_SRET = 17752064, O_SHGRN = 21946368, O_SS5R = 26140672, O_SS5I = 26402816, O_SM2 = 26664960, O_SCONV = 30859264, O_TOTAL = 31252480;
constexpr size_t MiB = 1u << 20;
constexpr size_t WS_CTL = 0, CTL_ZERO_BYTES = 1 * MiB;
constexpr size_t WS_WINT = 2 * MiB;
constexpr size_t WS_WOUTT = 15 * MiB;
constexpr size_t WS_WGLUT = 19 * MiB;
constexpr size_t WS_ROTC = 19 * MiB + 512 * 1024;
constexpr size_t WS_ROTS = 20 * MiB;
constexpr size_t WS_S5AB = 20 * MiB + 512 * 1024;
constexpr size_t WS_S5BB = 20 * MiB + 768 * 1024;
constexpr size_t WS_LB = 21 * MiB + 512 * 1024;
constexpr size_t WS_DT = 22 * MiB;
constexpr size_t WS_MSQ = 22 * MiB + 512 * 1024;
constexpr size_t WS_XB = 24 * MiB;
constexpr size_t WS_MIXED = 57 * MiB;
constexpr size_t WS_GY = 90 * MiB;
constexpr size_t WS_PROJ = 100 * MiB;
constexpr size_t WS_ZB = 206 * MiB;
constexpr size_t WS_END = 256 * MiB;
constexpr int CW_BAR = 4096;
constexpr int RING_OFF = 0, RING_BYTES = 131072;
constexpr int LDSCTL_OFF = RING_BYTES, MISC_OFF = LDSCTL_OFF + 320;
constexpr int LDS_BYTES = 147456;

#define GAS __attribute__((address_space(1)))
#define LAS __attribute__((address_space(3)))
#define DI __device__ __forceinline__
typedef unsigned short bf16;
typedef unsigned v4u __attribute__((ext_vector_type(4)));
typedef unsigned v2u __attribute__((ext_vector_type(2)));
typedef float f32x4 __attribute__((ext_vector_type(4)));
typedef GAS unsigned gu32;
#define RLX_AGENT __ATOMIC_RELAXED, __HIP_MEMORY_SCOPE_AGENT
#define LDS_WAIT() asm volatile("s_waitcnt lgkmcnt(0)" ::: "memory")
#define VM_WAIT() asm volatile("s_waitcnt vmcnt(0)" ::: "memory")
DI unsigned f2bf(float f) { unsigned u = __builtin_bit_cast(unsigned, f); return (u + 0x7fffu + ((u >> 16) & 1u)) >> 16; }
DI unsigned pk2(float lo, float hi) { return f2bf(lo) | (f2bf(hi) << 16); }
using pg8::bf2f; using pg8::ex2; using pg8::fexp; using pg8::sigm; using pg8::silu;

#define XB_TMO      128
#define XB_XCNT(j)  (256  + 64 * (j))
#define XB_XSUB(j)  (1280 + 64 * (j))
#define XB_XGEN(j)  (2304 + 64 * (j))
#define XB_TOP      3328
#define XB_TOPGEN   3392
#define XCD_BAR_WORDS 3456
#define XB_SPIN_CAP (1u << 18)

__device__ __forceinline__ unsigned xb_ld(unsigned* p)              { return __hip_atomic_load(p, __ATOMIC_RELAXED, __HIP_MEMORY_SCOPE_AGENT); }
__device__ __forceinline__ unsigned xb_add(unsigned* p, unsigned v) { return __hip_atomic_fetch_add(p, v, __ATOMIC_RELAXED, __HIP_MEMORY_SCOPE_AGENT); }
__device__ __forceinline__ unsigned xb_xcc_id() { return (unsigned)__builtin_amdgcn_s_getreg((3 << 11) | 20) & 0xFu; }
#define XB_SPIN(cond, bar) do { unsigned _sp = 0; while (cond) { __builtin_amdgcn_s_sleep(1); \
    if ((++_sp & 255u) == 0u) { if (xb_ld(&(bar)[XB_TMO])) break; if (_sp > XB_SPIN_CAP) { atomicAdd(&(bar)[XB_TMO], 1u); break; } } } } while (0)

struct XcdBarrier {
    unsigned* bar; unsigned x;
    volatile LAS unsigned* st;
};

__device__ __forceinline__ XcdBarrier xcd_barrier_post(unsigned* bar, volatile LAS unsigned* st) {
    XcdBarrier b; b.bar = bar; b.x = xb_xcc_id(); b.st = st;
    if (threadIdx.x == 0) (void)xb_add(&bar[XB_XCNT(b.x)], 1u);
    return b;
}
__device__ __forceinline__ void xcd_barrier_complete(unsigned* bar, unsigned x, unsigned& nloc, unsigned& nx) {
    const unsigned G = gridDim.x * gridDim.y * gridDim.z;
    unsigned sum, cnt, mine, sp = 0u;
    for (;;) {
        sum = 0u; cnt = 0u; mine = 0u;
#pragma unroll
        for (unsigned j = 0; j < 16; ++j) { const unsigned c = xb_ld(&bar[XB_XCNT(j)]); sum += c; cnt += (c > 0u) ? 1u : 0u; mine = (j == x) ? c : mine; }
        if (sum == G) break;
        __builtin_amdgcn_s_sleep(1);
        if ((++sp & 255u) == 0u) { if (xb_ld(&bar[XB_TMO])) break; if (sp > XB_SPIN_CAP) { atomicAdd(&bar[XB_TMO], 1u); break; } }
    }
    nloc = mine > 0u ? mine : 1u; nx = cnt > 0u ? cnt : 1u;
}

__device__ __forceinline__ void xcd_barrier(const XcdBarrier& b) {
    asm volatile("s_waitcnt vmcnt(0)" ::: "memory");
    __syncthreads();
    if (threadIdx.x == 0) {
        unsigned* bar = b.bar;
        __builtin_amdgcn_s_waitcnt(0);
        unsigned nloc = b.st[0], nx = b.st[1];
        if (nloc == 0u) { xcd_barrier_complete(bar, b.x, nloc, nx); b.st[0] = nloc; b.st[1] = nx; }
        const unsigned old = xb_add(&bar[XB_XSUB(b.x)], 1u);
        const unsigned gen = old / nloc;
        if (old + 1u == (gen + 1u) * nloc) {
            __builtin_amdgcn_fence(__ATOMIC_RELEASE, "agent");
            asm volatile("s_waitcnt vmcnt(0)" ::: "memory");
            const unsigned og = xb_add(&bar[XB_TOP], 1u);
            const unsigned tg = og / nx;
            if (og + 1u == (tg + 1u) * nx) xb_add(&bar[XB_TOPGEN], 1u);
            else XB_SPIN(xb_ld(&bar[XB_TOPGEN]) == tg, bar);
            __builtin_amdgcn_fence(__ATOMIC_ACQUIRE, "agent");
            xb_add(&bar[XB_XGEN(b.x)], 1u);
            asm volatile("s_waitcnt vmcnt(0)" ::: "memory");
        } else {
            XB_SPIN(xb_ld(&bar[XB_XGEN(b.x)]) == gen, bar);
            __builtin_amdgcn_fence(__ATOMIC_ACQUIRE, "agent");
            asm volatile("s_waitcnt vmcnt(0)" ::: "memory");
        }
    }
    __syncthreads();
}

struct Args { const float* in[31]; float* out; unsigned char* ws; int ph_lo, ph_hi, li, pad; };
struct Frame {
    LAS unsigned char* lds; volatile LAS unsigned* MISC; gu32* ctl;
    int tid, lane, wave, vcu, G;
    const float* const* ka; float* out_; unsigned char* ws_;
};
DI const float* INP(const Frame& F, int i) { const float* const* t = F.ka; asm volatile("" : "+s"(t)); return t[i]; }
DI unsigned char* WSP(const Frame& F) { unsigned char* w = F.ws_; asm volatile("" : "+s"(w)); return w; }
DI float* OUTP(const Frame& F) { float* o = F.out_; asm volatile("" : "+s"(o)); return o; }
DI float wave_sum(float v) {
#pragma unroll
    for (int o = 1; o < 64; o <<= 1) v += __shfl_xor(v, o);
    return v;
}
DI void sincos_acc(float ang, float& s, float& c) {
    const float C1 = 0.15915493667125702f, C2 = 6.4206382432985265e-09f;
    const float hi = ang * C1, lo = __builtin_fmaf(ang, C1, -hi) + ang * C2;
    const float f = (hi - __builtin_rintf(hi)) + lo;
    const float qf = __builtin_rintf(4.f * f); const int q = (int)qf;
    const float u = __builtin_fmaf(-0.25f, qf, f);
    const float r = __builtin_fmaf(u, 6.2831854820251465f, u * -1.7484555314695172e-07f);
    const float r2 = r * r;
    float sp = 2.7557319e-06f; sp = __builtin_fmaf(sp, r2, -1.9841270e-04f); sp = __builtin_fmaf(sp, r2, 8.3333333e-03f); sp = __builtin_fmaf(sp, r2, -1.6666667e-01f);
    const float sn = __builtin_fmaf(r * r2, sp, r);
    float cp = -2.7557319e-07f; cp = __builtin_fmaf(cp, r2, 2.4801587e-05f); cp = __builtin_fmaf(cp, r2, -1.3888889e-03f); cp = __builtin_fmaf(cp, r2, 4.1666667e-02f); cp = __builtin_fmaf(cp, r2, -0.5f);
    const float cs = __builtin_fmaf(r2, cp, 1.f);
    const int qq = q & 3;
    s = qq == 0 ? sn : qq == 1 ? cs : qq == 2 ? -sn : -cs;
    c = qq == 0 ? cs : qq == 1 ? -sn : qq == 2 ? -cs : sn;
}
__device__ __constant__ float ROT_INV[32] = {1.000000000e+00f, 7.498942018e-01f, 5.623413324e-01f, 4.216965139e-01f, 3.162277639e-01f, 2.371373773e-01f, 1.778279394e-01f, 1.333521456e-01f, 1.000000015e-01f, 7.498942316e-02f, 5.623413250e-02f, 4.216964915e-02f, 3.162277490e-02f, 2.371373773e-02f, 1.778279431e-02f, 1.333521400e-02f, 9.999999776e-03f, 7.498942316e-03f, 5.623413250e-03f, 4.216964822e-03f, 3.162277630e-03f, 2.371373819e-03f, 1.778279431e-03f, 1.333521446e-03f, 1.000000047e-03f, 7.498941850e-04f, 5.623413017e-04f, 4.216965172e-04f, 3.162277571e-04f, 2.371373703e-04f, 1.778279402e-04f, 1.333521504e-04f};
DI void transpose_item(const float* W, int K, int ld, int nblk, bf16* WT, LAS float* scr, int item, int lane) {
    const int kb = item / nblk, nb = item % nblk, k0 = 64 * kb, n0 = 32 * nb;
#pragma unroll 8
    for (int i = 0; i < 32; ++i) { const int kk = 2 * i + (lane >> 5); scr[kk * 33 + (lane & 31)] = W[(size_t)(k0 + kk) * ld + n0 + (lane & 31)]; }
    LDS_WAIT(); asm volatile("" ::: "memory");
    const int c = lane & 7;
#pragma unroll
    for (int j = 0; j < 4; ++j) { const int n = (lane >> 3) + 8 * j; const LAS float* s = scr + (8 * c) * 33 + n;
        v4u o; o.x = pk2(s[0 * 33], s[1 * 33]); o.y = pk2(s[2 * 33], s[3 * 33]); o.z = pk2(s[4 * 33], s[5 * 33]); o.w = pk2(s[6 * 33], s[7 * 33]);
        *(GAS v4u*)(WT + (size_t)(n0 + n) * K + k0 + 8 * c) = o; }
    LDS_WAIT(); asm volatile("" ::: "memory");
}
DI void aprep(Frame& F, int layer) {
    LAS f32x4* wdt = (LAS f32x4*)(F.lds + RING_OFF);
    const float* Win = INP(F, 9) + (size_t)layer * DM * NPROJ_FULL;
    for (int k = F.tid; k < DM; k += NTHR) wdt[k] = *(const f32x4*)(Win + (size_t)k * NPROJ_FULL + NPROJ);
    __syncthreads();
    const float* nw = INP(F, 8) + layer * DM;
    bf16* XB = (bf16*)(WSP(F) + WS_XB); float* DT = (float*)(WSP(F) + WS_DT);
    const int gw = F.vcu * NWAVES + F.wave, NGW = F.G * NWAVES, lane = F.lane;
    f32x4 nwv[4];
#pragma unroll
    for (int j = 0; j < 4; ++j) nwv[j] = *((const f32x4*)nw + lane + 64 * j);
    for (int m = gw; m < MPAD; m += NGW) {
        GAS unsigned long long* o8 = (GAS unsigned long long*)(XB + (size_t)m * DM) + lane;
        if (m >= MVALID) {
#pragma unroll
            for (int j = 0; j < 4; ++j) o8[64 * j] = 0ull;
            continue; }
        const float* src = layer == 0 ? (m < MPROMPT ? INP(F, 0) + (size_t)m * DM : INP(F, 1) + (size_t)(m - MPROMPT) * DM) : OUTP(F) + (size_t)m * DM;
        const f32x4* xr = (const f32x4*)src + lane;
        f32x4 v[4]; float ss = 0.f;
#pragma unroll
        for (int j = 0; j < 4; ++j) { v[j] = xr[64 * j]; ss += (v[j].x * v[j].x + v[j].y * v[j].y) + (v[j].z * v[j].z + v[j].w * v[j].w); }
        const float rstd = 1.f / sqrtf(wave_sum(ss) * (1.f / DM) + EPS);
        f32x4 d = (f32x4){0.f, 0.f, 0.f, 0.f};
#pragma unroll
        for (int j = 0; j < 4; ++j) { v[j] = v[j] * rstd * nwv[j];
            const int k = 4 * (lane + 64 * j);
            d += wdt[k] * v[j].x; d += wdt[k + 1] * v[j].y; d += wdt[k + 2] * v[j].z; d += wdt[k + 3] * v[j].w;
            o8[64 * j] = (unsigned long long)pk2(v[j].x, v[j].y) | ((unsigned long long)pk2(v[j].z, v[j].w) << 32); }
        d.x = wave_sum(d.x); d.y = wave_sum(d.y); d.z = wave_sum(d.z); d.w = wave_sum(d.w);
        if (lane == 0) *(f32x4*)(DT + (size_t)m * 4) = d;
    }
}
DI void final_norm(Frame& F) {
    const float* fw = INP(F, 30);
    const int gw = F.vcu * NWAVES + F.wave, NGW = F.G * NWAVES, lane = F.lane;
    f32x4 nwv[4];
#pragma unroll
    for (int j = 0; j < 4; ++j) nwv[j] = *((const f32x4*)fw + lane + 64 * j);
    for (int m = gw; m < MVALID; m += NGW) {
        f32x4* xr = (f32x4*)(OUTP(F) + (size_t)m * DM) + lane;
        f32x4 v[4]; float ss = 0.f;
#pragma unroll
        for (int j = 0; j < 4; ++j) { v[j] = xr[64 * j]; ss += (v[j].x * v[j].x + v[j].y * v[j].y) + (v[j].z * v[j].z + v[j].w * v[j].w); }
        const float rstd = 1.f / sqrtf(wave_sum(ss) * (1.f / DM) + EPS);
#pragma unroll
        for (int j = 0; j < 4; ++j) xr[64 * j] = v[j] * rstd * nwv[j];
    }
}
DI void prologue(Frame& F) {
    LAS float* scr = (LAS float*)(F.lds + RING_OFF + 16384 + F.wave * 12288);
    const int gw = F.vcu * NWAVES + F.wave, NGW = F.G * NWAVES;
    constexpr int I_IN = 16 * 104, I_OUT = 16 * 32, I_GLU = 4 * 8, I_L = I_IN + I_OUT + I_GLU;
    for (int it = gw; it < 2 * I_L; it += NGW) {
        const int l = it / I_L; int r = it % I_L;
        if (r < I_IN) { transpose_item(INP(F, 9) + (size_t)l * DM * NPROJ_FULL, DM, NPROJ_FULL, 104, (bf16*)(WSP(F) + WS_WINT) + (size_t)l * NPROJ * DM, scr, r, F.lane); continue; } r -= I_IN;
        if (r < I_OUT) { transpose_item(INP(F, 29) + (size_t)l * DM * DM, DM, DM, 32, (bf16*)(WSP(F) + WS_WOUTT) + (size_t)l * DM * DM, scr, r, F.lane); continue; } r -= I_OUT;
        transpose_item(INP(F, 21) + (size_t)l * 65536, 256, 256, 8, (bf16*)(WSP(F) + WS_WGLUT) + (size_t)l * 65536, scr, r, F.lane);
    }
    const int gt = F.vcu * NTHR + F.tid, NGT = F.G * NTHR;
    float* RC = (float*)(WSP(F) + WS_ROTC); float* RS = (float*)(WSP(F) + WS_ROTS);
    for (int idx = gt; idx < 2049 * 32; idx += NGT) {
        const int p = idx >> 5, i = idx & 31; const float pos = p < 2048 ? (float)p : 16384.f;
        const float ang = pos * ROT_INV[i];
        float s, c; sincos_acc(ang, s, c); RC[idx] = c; RS[idx] = s;
    }
    float* AB = (float*)(WSP(F) + WS_S5AB); float* BB = (float*)(WSP(F) + WS_S5BB);
    for (int idx = gt; idx < 2 * 16 * 64; idx += NGT) {
        const int l = idx >> 10, g = (idx >> 6) & 15;
        const float are = INP(F, 13)[idx], aim = INP(F, 14)[idx], dt = expf(INP(F, 15)[l * 16 + g]);
        const float mag = expf(are * dt); float s, c; sincos_acc(aim * dt, s, c);
        const float abr = mag * c, abi = mag * s; AB[2 * idx] = abr; AB[2 * idx + 1] = abi;
        const float nr = abr - 1.f, ni = abi, den = are * are + aim * aim;
        const float fr = (nr * are + ni * aim) / den, fi = (ni * are - nr * aim) / den;
        for (int cc = 0; cc < 16; ++cc) { const float br = INP(F, 16)[(size_t)idx * 16 + cc], bi = INP(F, 17)[(size_t)idx * 16 + cc];
            BB[((size_t)idx * 16 + cc) * 2] = fr * br - fi * bi; BB[((size_t)idx * 16 + cc) * 2 + 1] = fr * bi + fi * br; }
    }
    float* LB = (float*)(WSP(F) + WS_LB);
    for (int idx = gt; idx < 256; idx += NGT) {
        const float l0 = INP(F, 11)[idx], l1 = INP(F, 11)[256 + idx], mx = fmaxf(l0, l1), e0 = expf(l0 - mx), e1 = expf(l1 - mx);
        const float s0 = e0 / (e0 + e1), s1 = e1 / (e0 + e1);
        LB[idx] = fminf(fmaxf(s0 - s0, 0.f), 1.f); LB[256 + idx] = fminf(fmaxf((s0 + s1) - s0, 0.f), 1.f);
    }
    __syncthreads();
    aprep(F, 0);
}
DI float gelu_tanh(float x) { const float u = 0.7978845608028654f * (x + 0.044715f * x * x * x); const float t = 1.f - 2.f / (1.f + fexp(2.f * u)); return 0.5f * x * (1.f + t); }
DI float softplus(float x) { return fmaxf(x, 0.f) + log1pf(expf(-fabsf(x))); }
DI void linrec_unit(Frame& F, int layer, int branch, int h, int row0, int ntok, int rot0, const float* h0, float* hout, const float* cb0, float* cbout) {
    LAS float* Q = (LAS float*)(F.lds + RING_OFF); LAS float* K = Q + 4096; LAS float* V = K + 4096; LAS float* A = V + 4096; LAS float* O = A + 4096; LAS float* Gt = O + 4096; LAS float* X = Gt + 4096;
    const bf16* P = (const bf16*)(WSP(F) + WS_PROJ); bf16* MX = (bf16*)(WSP(F) + WS_MIXED);
    const float* RC = (const float*)(WSP(F) + WS_ROTC); const float* RS = (const float*)(WSP(F) + WS_ROTS); const float* LB = (const float*)(WSP(F) + WS_LB) + layer * 256;
    const float* DT = (const float*)(WSP(F) + WS_DT); float* MSQ = (float*)(WSP(F) + WS_MSQ);
    const int tid = F.tid, w = F.wave, lane = F.lane, vi = lane & 7, kg = lane >> 3, v = 8 * w + vi;
    float hs[8];
#pragma unroll
    for (int j = 0; j < 8; ++j) hs[j] = h0 ? h0[(8 * kg + j) * 64 + v] : 0.f;
    const float gamma = 1.f - ex2(-5.f - (float)h);
    const float* cw = INP(F, 23) + layer * 2048; const float* cbias = INP(F, 24) + layer * 512;
    const float dtb = INP(F, 25)[layer * 4 + h], Ah = -expf(INP(F, 26)[layer * 4 + h]), Dh = INP(F, 27)[layer * 4 + h];
    const int g2 = h >> 1;
    for (int c0 = 0; c0 < ntok; c0 += 64) {
        const int nt = (ntok - c0) < 64 ? (ntok - c0) : 64;
        __syncthreads();
        for (int e = tid; e < 4096; e += NTHR) {
            const int t = e >> 6, ch = e & 63; if (t >= nt) continue;
            const size_t r = (size_t)(row0 + c0 + t); const bf16* pr = P + r * NPROJ;
            if (branch == 0) {
                const int i = ch & 31; const float cs = RC[(rot0 + c0 + t) * 32 + i], sn = RS[(rot0 + c0 + t) * 32 + i];
                const float q1 = bf2f(pr[h * 64 + i]), q2 = bf2f(pr[h * 64 + 32 + i]), k1 = bf2f(pr[256 + h * 64 + i]), k2 = bf2f(pr[256 + h * 64 + 32 + i]);
                Q[e] = ch < 32 ? q1 * cs - q2 * sn : q1 * sn + q2 * cs;
                K[e] = (ch < 32 ? k1 * cs - k2 * sn : k1 * sn + k2 * cs) * 0.125f;
                V[e] = bf2f(pr[512 + h * 64 + ch]); A[e] = gamma; Gt[e] = bf2f(pr[768 + h * 64 + ch]);
            } else if (branch == 1) {
                const float fr = bf2f(pr[1280 + h * 64 + ch]), lb = LB[h * 64 + ch], sg = sigm(fr);
                Q[e] = silu(bf2f(pr[1024 + h * 64 + ch])); A[e] = lb + (1.f - lb) * sg; K[e] = (1.f - lb) * sigm(-fr);
                V[e] = bf2f(pr[1536 + h * 64 + ch]); Gt[e] = bf2f(pr[1792 + h * 64 + ch]);
            } else {
                const int cx = h * 64 + ch, cB = 256 + g2 * 64 + ch, cC = 384 + g2 * 64 + ch;
                float ax = cbias[cx], aB = cbias[cB], aC = cbias[cC];
#pragma unroll
                for (int i = 0; i < 4; ++i) { const int tt = c0 + t - 3 + i; float rx, rB, rC;
                    if (tt >= 0) { const bf16* p2 = P + (size_t)(row0 + tt) * NPROJ + 2816; rx = bf2f(p2[cx]); rB = bf2f(p2[cB]); rC = bf2f(p2[cC]); }
                    else if (cb0) { rx = cb0[(3 + tt) * 512 + cx]; rB = cb0[(3 + tt) * 512 + cB]; rC = cb0[(3 + tt) * 512 + cC]; }
                    else { rx = 0.f; rB = 0.f; rC = 0.f; }
                    ax += cw[i * 512 + cx] * rx; aB += cw[i * 512 + cB] * rB; aC += cw[i * 512 + cC] * rC; }
                const float xc = silu(ax), dt = softplus(DT[r * 4 + h] + dtb);
                Q[e] = silu(aC); K[e] = silu(aB); V[e] = xc * dt; A[e] = expf(dt * Ah); X[e] = xc; Gt[e] = bf2f(pr[2560 + h * 64 + ch]);
            }
        }
        __syncthreads();
        for (int t = 0; t < nt; ++t) {
            const LAS float* q = Q + t * 64 + 8 * kg; const LAS float* k = K + t * 64 + 8 * kg; const LAS float* a = A + t * 64 + 8 * kg; const float vv = V[t * 64 + v];
            float p = 0.f;
#pragma unroll
            for (int j = 0; j < 8; ++j) { hs[j] = a[j] * hs[j] + k[j] * vv; p += q[j] * hs[j]; }
            p += __shfl_xor(p, 8); p += __shfl_xor(p, 16); p += __shfl_xor(p, 32);
            if (kg == 0) O[t * 64 + v] = p;
        }
        __syncthreads();
        {
            const int t = tid >> 3, sub = tid & 7; const size_t r = (size_t)(row0 + c0 + t);
            float o[8]; float ss = 0.f;
#pragma unroll
            for (int j = 0; j < 8; ++j) { const int e = t * 64 + sub * 8 + j; float x = O[e]; if (branch == 2) x = (x + Dh * X[e]) * silu(Gt[e]); o[j] = x; ss += x * x; }
            ss += __shfl_xor(ss, 1); ss += __shfl_xor(ss, 2); ss += __shfl_xor(ss, 4);
            if (t < nt) {
                if (branch != 2) { const float sc = 1.f / sqrtf(ss * (1.f / 64.f) + EPS); const float* nw = INP(F, branch == 0 ? 10 : 12) + layer * 256 + h * 64 + sub * 8;
#pragma unroll
                    for (int j = 0; j < 8; ++j) o[j] = o[j] * sc * nw[j] * silu(Gt[t * 64 + sub * 8 + j]); }
                else if (sub == 0) MSQ[r * 4 + h] = ss;
                v4u wv; wv.x = pk2(o[0], o[1]); wv.y = pk2(o[2], o[3]); wv.z = pk2(o[4], o[5]); wv.w = pk2(o[6], o[7]);
                *(v4u*)(MX + r * DM + branch * 256 + (branch == 2 ? 256 : 0) + h * 64 + sub * 8) = wv;
            }
        }
    }
#pragma unroll
    for (int j = 0; j < 8; ++j) hout[(8 * kg + j) * 64 + v] = hs[j];
    if (branch == 2 && h == 0) {
        for (int e = tid; e < 1536; e += NTHR) { const int i = e / 512, cc = e % 512, tt = ntok - 3 + i;
            cbout[e] = tt >= 0 ? bf2f(P[(size_t)(row0 + tt) * NPROJ + 2816 + cc]) : (cb0 ? cb0[(3 + tt) * 512 + cc] : 0.f); }
    }
}
DI void s5_unit(Frame& F, int layer, int g, int row0, int ntok, const float* h0r, const float* h0i, float* hor, float* hoi) {
    LAS float* U = (LAS float*)(F.lds + RING_OFF); LAS float* H = U + 1024; LAS float* Cr = H + 8192; LAS float* Ci = Cr + 1024;
    const bf16* P = (const bf16*)(WSP(F) + WS_PROJ); bf16* GY = (bf16*)(WSP(F) + WS_GY);
    const int tid = F.tid;
    __syncthreads();
    for (int e = tid; e < 1024; e += NTHR) { Cr[e] = INP(F, 18)[(size_t)(layer * 16 + g) * 1024 + e]; Ci[e] = INP(F, 19)[(size_t)(layer * 16 + g) * 1024 + e]; }
    float hr = 0.f, hi = 0.f, abr = 0.f, abi = 0.f; float bbr[16], bbi[16];
    if (tid < 64) { const int idx = (layer * 16 + g) * 64 + tid; const float* AB = (const float*)(WSP(F) + WS_S5AB); const float* BB = (const float*)(WSP(F) + WS_S5BB);
        abr = AB[2 * idx]; abi = AB[2 * idx + 1];
#pragma unroll
        for (int c = 0; c < 16; ++c) { bbr[c] = BB[((size_t)idx * 16 + c) * 2]; bbi[c] = BB[((size_t)idx * 16 + c) * 2 + 1]; }
        if (h0r) { hr = h0r[tid]; hi = h0i[tid]; } }
    const float* Dv = INP(F, 20) + layer * 256 + g * 16;
    for (int c0 = 0; c0 < ntok; c0 += 64) {
        const int nt = (ntok - c0) < 64 ? (ntok - c0) : 64;
        __syncthreads();
        for (int e = tid; e < 1024; e += NTHR) { const int t = e >> 4, c = e & 15; if (t < nt) U[e] = bf2f(P[(size_t)(row0 + c0 + t) * NPROJ + 2048 + g * 16 + c]); }
        __syncthreads();
        if (tid < 64) {
            for (int t = 0; t < nt; ++t) {
                float br = 0.f, bi = 0.f;
#pragma unroll
                for (int c = 0; c < 16; ++c) { const float u = U[t * 16 + c]; br += bbr[c] * u; bi += bbi[c] * u; }
                const float nr = abr * hr - abi * hi + br, ni = abr * hi + abi * hr + bi; hr = nr; hi = ni;
                H[(t * 64 + tid) * 2] = hr; H[(t * 64 + tid) * 2 + 1] = hi;
            }
        }
        __syncthreads();
        for (int e = tid; e < 1024; e += NTHR) { const int t = e >> 4, c = e & 15; if (t >= nt) continue;
            float y = 0.f;
            for (int p = 0; p < 64; ++p) y += Cr[c * 64 + p] * H[(t * 64 + p) * 2] - Ci[c * 64 + p] * H[(t * 64 + p) * 2 + 1];
            const float sy = y + Dv[c] * U[e];
            GY[(size_t)(row0 + c0 + t) * 256 + g * 16 + c] = (bf16)f2bf(gelu_tanh(sy)); }
    }
    if (tid < 64) { hor[tid] = hr; hoi[tid] = hi; }
}
DI void mixers_naive(Frame& F, int l) {
    float* out = OUTP(F);
    constexpr int U_LR = 96, U_S5 = 128, U_SLR = 1536, U_SS5 = 2048, U_ALL = U_LR + U_S5 + U_SLR + U_SS5;
    for (int u = blockIdx.x; u < U_ALL; u += F.G) {
        int r = u;
        if (r < U_LR) { const int b = r / 12, hid = r % 12, br = hid >> 2, h = hid & 3;
            float* ho = out + (br == 0 ? O_PRET : br == 1 ? O_PHGRN : O_PM2) + (size_t)((l * NB + b) * 4 + h) * 4096;
            linrec_unit(F, l, br, h, b * SEQL, SEQL, 0, nullptr, ho, nullptr, out + O_PCONV + (size_t)(l * NB + b) * 1536); continue; } r -= U_LR;
        if (r < U_S5) { const int b = r >> 4, g = r & 15;
            s5_unit(F, l, g, b * SEQL, SEQL, nullptr, nullptr, out + O_PS5R + (size_t)((l * NB + b) * 16 + g) * 64, out + O_PS5I + (size_t)((l * NB + b) * 16 + g) * 64); continue; } r -= U_S5;
        if (r < U_SLR) { const int s = r / 12, hid = r % 12, br = hid >> 2, h = hid & 3;
            const size_t so = (size_t)((l * MSAMP + s) * 4 + h) * 4096;
            const float* hi = INP(F, br == 0 ? 2 : br == 1 ? 3 : 6) + so; float* ho = out + (br == 0 ? O_SRET : br == 1 ? O_SHGRN : O_SM2) + so;
            linrec_unit(F, l, br, h, MPROMPT + s, 1, 2048, hi, ho, INP(F, 7) + (size_t)(l * MSAMP + s) * 1536, out + O_SCONV + (size_t)(l * MSAMP + s) * 1536); continue; } r -= U_SLR;
        { const int s = r >> 4, g = r & 15; const size_t so = (size_t)((l * MSAMP + s) * 16 + g) * 64;
            s5_unit(F, l, g, MPROMPT + s, 1, INP(F, 4) + so, INP(F, 5) + so, out + O_SS5R + so, out + O_SS5I + so); }
    }
}
DI void fixups(Frame& F, int l) {
    unsigned char* ws = WSP(F);
    bf16* MX = (bf16*)(ws + WS_MIXED); const float* MSQ = (const float*)(ws + WS_MSQ); const float* nw = INP(F, 28) + l * 256;
    const bf16* GY = (const bf16*)(ws + WS_GY); const bf16* ZB = (const bf16*)(ws + WS_ZB); const bf16* PJ = (const bf16*)(ws + WS_PROJ);
    const int gw = F.vcu * NWAVES + F.wave, NGW = F.G * NWAVES, lane = F.lane;
    const f32x4 w4 = *((const f32x4*)nw + lane);
    for (int m = gw; m < MVALID; m += NGW) {
        const f32x4 q = *(const f32x4*)(MSQ + (size_t)m * 4); const float sc = 1.f / sqrtf(((q.x + q.y) + (q.z + q.w)) * (1.f / 256.f) + EPS);
        v2u* p = (v2u*)(MX + (size_t)m * DM + 768) + lane; const v2u x = *p;
        v2u o; o.x = pk2(__uint_as_float(x.x << 16) * sc * w4.x, __uint_as_float(x.x & 0xffff0000u) * sc * w4.y); o.y = pk2(__uint_as_float(x.y << 16) * sc * w4.z, __uint_as_float(x.y & 0xffff0000u) * sc * w4.w);
        *p = o;
        const v2u g = *((const v2u*)(GY + (size_t)m * 256) + lane), z = *((const v2u*)(ZB + (size_t)m * 256) + lane), sg = *((const v2u*)(PJ + (size_t)m * NPROJ + 2304) + lane);
        float r[4];
#pragma unroll
        for (int i = 0; i < 2; ++i) {
            r[2 * i] = __uint_as_float(g[i] << 16) * sigm(__uint_as_float(z[i] << 16)) * silu(__uint_as_float(sg[i] << 16));
            r[2 * i + 1] = __uint_as_float(g[i] & 0xffff0000u) * sigm(__uint_as_float(z[i] & 0xffff0000u)) * silu(__uint_as_float(sg[i] & 0xffff0000u)); }
        v2u o2; o2.x = pk2(r[0], r[1]); o2.y = pk2(r[2], r[3]);
        *((v2u*)(MX + (size_t)m * DM + 512) + lane) = o2;
    }
}
__global__ void __launch_bounds__(NTHR, 2) mk_fwd(Args args) {
    extern __shared__ __attribute__((aligned(16))) unsigned char lds[];
    Frame F;
    F.lds = (LAS unsigned char*)lds; F.MISC = (volatile LAS unsigned*)(F.lds + MISC_OFF);
    const int wave0 = __builtin_amdgcn_readfirstlane(threadIdx.x >> 6);
    F.tid = threadIdx.x; F.lane = F.tid & 63; F.wave = wave0;
    F.G = gridDim.x; { const int bx = blockIdx.x; F.vcu = (F.G % 8 == 0) ? (bx % 8) * (F.G / 8) + bx / 8 : bx; }
    F.ka = (const float* const*)__builtin_amdgcn_kernarg_segment_ptr(); F.out_ = args.out; F.ws_ = args.ws; F.ctl = (gu32*)(args.ws + WS_CTL);
    for (int u = F.tid; u < (LDS_BYTES - LDSCTL_OFF) / 4; u += NTHR) ((LAS unsigned*)(F.lds + LDSCTL_OFF))[u] = 0u;
    __syncthreads();
    XcdBarrier bar; bar.bar = (unsigned*)(F.ctl + CW_BAR); bar.x = 0; bar.st = nullptr;
    if (MK_N_LAUNCHES == 1) bar = xcd_barrier_post((unsigned*)(F.ctl + CW_BAR), F.MISC + 8);
    const int lo = args.ph_lo, hi = args.ph_hi;
#pragma unroll 1
    for (int ph = lo; ph < hi; ++ph) {
        int tid = wave0 * 64 + (int)__builtin_amdgcn_mbcnt_hi(~0u, __builtin_amdgcn_mbcnt_lo(~0u, 0u)); asm volatile("" : "+v"(tid));
        F.tid = tid; F.lane = tid & 63; F.wave = __builtin_amdgcn_readfirstlane(tid >> 6);
        const int l = ph >= 7 ? 1 : 0, sub = ph == 0 ? -1 : ph - 1 - 6 * l;
        if (ph == 0) { prologue(F); }
        else if (sub == 0) {
            unsigned char* ws = WSP(F); bf16* XB = (bf16*)(ws + WS_XB); bf16* PROJ = (bf16*)(ws + WS_PROJ);
            pg8::Gemm g{XB, (const bf16*)(ws + WS_WINT) + (size_t)l * NPROJ * DM, MPAD, NPROJ, DM}; pg8::StaticOrder S; S.init(MPAD, NPROJ, F.G, (int)blockIdx.x);
            pg8::EpiBf16<0> E{PROJ, NPROJ, nullptr, 0, 0, 1.f};
            pg8::gemm_phase<pg8::EpiBf16<0>, pg8::StaticOrder, true, true>(F.lds + RING_OFF, g, S, E, tid);
        } else if (sub == 1) { mixers_naive(F, l); }
        else if (sub == 2) {
            unsigned char* ws = WSP(F); bf16* GY = (bf16*)(ws + WS_GY);
            pg8::Gemm g{GY, (const bf16*)(ws + WS_WGLUT) + (size_t)l * 65536, MPAD, 256, 256}; pg8::StaticOrder S; S.init(MPAD, 256, F.G, (int)blockIdx.x);
            pg8::EpiBf16<0> E{(bf16*)(ws + WS_ZB), 256, INP(F, 22) + l * 256, 0, 0, 1.f};
            pg8::gemm_phase<pg8::EpiBf16<0>, pg8::StaticOrder, true, true>(F.lds + RING_OFF, g, S, E, tid);
        } else if (sub == 3) { fixups(F, l); }
        else if (sub == 4) {
            unsigned char* ws = WSP(F); bf16* MX = (bf16*)(ws + WS_MIXED);
            pg8::Gemm g{MX, (const bf16*)(ws + WS_WOUTT) + (size_t)l * DM * DM, MPAD, DM, DM}; pg8::StaticOrder S; S.init(MPAD, DM, F.G, (int)blockIdx.x);
            pg8::EpiResid E{INP(F, 0), INP(F, 1), OUTP(F), l == 0 ? 1 : 0};
            pg8::gemm_phase<pg8::EpiResid, pg8::StaticOrder, true, true>(F.lds + RING_OFF, g, S, E, tid);
        } else { if (l == 0) aprep(F, 1); else final_norm(F); }
        if (ph + 1 < hi) xcd_barrier(bar);
    }
}

extern "C" void kernel_launch(void* const* d_in, const int* in_sizes, int n_in, void* d_out, int out_size, void* d_ws, size_t ws_size, hipStream_t stream) {
    static int grid = 0;
    if (grid == 0) {
        if (n_in != 31 || out_size != (int)O_TOTAL || ws_size < WS_END) { fprintf(stderr, "kernel_launch: unexpected shapes: n_in %d out %d ws %zu\n", n_in, out_size, ws_size); grid = -1; return; }
        int dev = 0, cus = 0, per_cu = 0;
        if (hipGetDevice(&dev) != hipSuccess || hipDeviceGetAttribute(&cus, hipDeviceAttributeMultiprocessorCount, dev) != hipSuccess) { grid = -1; return; }
        if (hipFuncSetAttribute((const void*)mk_fwd, hipFuncAttributeMaxDynamicSharedMemorySize, LDS_BYTES) != hipSuccess) { fprintf(stderr, "kernel_launch: hipFuncSetAttribute failed\n"); grid = -1; return; }
        if (hipOccupancyMaxActiveBlocksPerMultiprocessor(&per_cu, (const void*)mk_fwd, NTHR, LDS_BYTES) != hipSuccess || per_cu < 1) { fprintf(stderr, "kernel_launch: occupancy query says %d\n", per_cu); per_cu = 1; }
        (void)hipGetLastError();
        grid = cus;
    }
    if (grid < 0) return;
    (void)hipMemsetAsync((char*)d_ws + WS_CTL, 0, CTL_ZERO_BYTES, stream);
    Args a{};
    for (int i = 0; i < 31; ++i) a.in[i] = (const float*)d_in[i];
    a.out = (float*)d_out; a.ws = (unsigned char*)d_ws;
    if (MK_N_LAUNCHES == 1) { a.ph_lo = 0; a.ph_hi = N_PHASES; a.li = 0; hipLaunchKernelGGL(mk_fwd, dim3(grid), dim3(NTHR), LDS_BYTES, stream, a); }
    else for (int p = 0; p < N_PHASES; ++p) { a.ph_lo = p; a.ph_hi = p + 1; a.li = p; hipLaunchKernelGGL(mk_fwd, dim3(grid), dim3(NTHR), LDS_BYTES, stream, a); }
}
```

```cpp
#include <hip/hip_runtime.h>
#include <cstdio>
#include <cstdint>
namespace pg8 {
#define PG8_LAS __attribute__((address_space(3)))
typedef unsigned short bf16_t;
typedef short bf16x8 __attribute__((ext_vector_type(8)));
typedef float f32x4 __attribute__((ext_vector_type(4)));
typedef unsigned u32x4 __attribute__((ext_vector_type(4)));
constexpr int BM = 256, BK = 64, HALF = 128, HTB = HALF * BK * 2  , STAGE_BYTES = 8 * HTB, NXCD = 8, WGM = 8;

__host__ __device__ __forceinline__ int lds_byte(int r, int c) { const int st = (r >> 4) * 2 + (c >> 5), rr = r & 15, cc = c & 31, ob = rr * 64 + cc * 2; return st * 1024 + (ob ^ (((ob >> 9) & 1) << 5)); }
__host__ __device__ __forceinline__ void stage_rc(int b, int& R, int& C) { const int st = b / 1024, sb = b % 1024, swz = sb ^ (((sb >> 9) & 1) << 5); R = (st >> 1) * 16 + swz / 64; C = (st & 1) * 32 + (swz % 64) / 2; }
__host__ __device__ __forceinline__ int perm32(int rho) { const int n = rho >> 4, i = rho & 15; return 8 * (i >> 2) + 4 * n + (i & 3); }

struct Unit { int pm, pn; };
struct Gemm { const bf16_t* A; const bf16_t* Bt; int M, N, K; };

struct StaticOrder {
    int nM, nN, nwg, G, c;
    __host__ __device__ void init(int M, int N, int G_, int c_) { nM = M / BM; nN = N / BM; nwg = nM * nN; G = G_; c = c_; }
    __host__ __device__ bool next(int i, Unit& u) const {
        const long L = (long)i * G + c; if (L >= nwg) return false;
        int wgid = (int)L; { const int q = nwg / NXCD, r = nwg % NXCD, xcd = wgid % NXCD, off = wgid / NXCD; wgid = (xcd < r ? xcd * (q + 1) : r * (q + 1) + (xcd - r) * q) + off; }
        const int nig = WGM * nN, gid = wgid / nig, fm = gid * WGM, gsz = (nM - fm) < WGM ? (nM - fm) : WGM;
        u.pm = fm + ((wgid % nig) % gsz); u.pn = (wgid % nig) / gsz; return true;
    }
    __device__ __forceinline__ void a_ready(const Unit&) const {}
    __device__ __forceinline__ void done(const Unit&) const {}
};

__device__ __forceinline__ unsigned cvt_pk_bf16(float lo, float hi) { unsigned r; asm volatile("v_cvt_pk_bf16_f32 %0, %1, %2" : "=v"(r) : "v"(lo), "v"(hi)); return r; }
typedef float f32x2 __attribute__((ext_vector_type(2)));
__device__ __forceinline__ f32x2 gelu_pk(f32x2 v) {
    const f32x2 av = __builtin_elementwise_abs(v), d = av * 0.2316418882f + 1.0f;
    f32x2 t; t.x = __builtin_amdgcn_rcpf(d.x); t.y = __builtin_amdgcn_rcpf(d.y);
    f32x2 q = t * 0.5307027145f + (-0.7265760135f); q = q * t + 0.7107068705f; q = q * t + (-0.142248368f); q = q * t + 0.127414796f; q = q * t;
    const f32x2 s = (v * v) * (-0.72134752044f);
    f32x2 e; e.x = __builtin_amdgcn_exp2f(s.x); e.y = __builtin_amdgcn_exp2f(s.y);
    const f32x2 m = v * (q * e), r = v - m;
    f32x2 o; o.x = v.x < 0.f ? m.x : r.x; o.y = v.y < 0.f ? m.y : r.y; return o;
}

template <int ACT  > struct EpiBf16 {
    static constexpr bool PERM = true, AFTER_DRAIN = false; static_assert(ACT == 0 || ACT == 1, "EpiBf16: ACT is 0 (none) or 1 (gelu_pk)");
    bf16_t* O; int ldc; const float* bias; int split_cols; size_t split_stride; float scale0;
    __device__ __forceinline__ void operator()(const f32x4 (&acc)[2][2][4][2], const Unit& u, int wr, int wc, int fr, int fq) const {
        const int row0 = u.pm * BM + wr * 64 + fr; int colt = u.pn * BM; bf16_t* base = O;
        float sc = 1.f; if (split_cols) { const int t = colt / split_cols; base += (size_t)t * split_stride; colt -= t * split_cols; if (t == 0) sc = scale0; }
        const int col0 = colt + wc * 32 + 8 * fq, bcol0 = u.pn * BM + wc * 32 + 8 * fq;
        f32x4 bv[2][2];
#pragma unroll
        for (int bj = 0; bj < 2; ++bj)
#pragma unroll
            for (int n = 0; n < 2; ++n) bv[bj][n] = bias ? *(const f32x4*)(bias + bcol0 + bj * HALF + 4 * n) : (f32x4){0.f, 0.f, 0.f, 0.f};
#pragma unroll
        for (int ai = 0; ai < 2; ++ai)
#pragma unroll
            for (int m = 0; m < 4; ++m) { bf16_t* rowp = base + (size_t)(row0 + ai * HALF + m * 16) * ldc + col0;
#pragma unroll
                for (int bj = 0; bj < 2; ++bj) { f32x4 v0 = acc[ai][bj][m][0] + bv[bj][0], v1 = acc[ai][bj][m][1] + bv[bj][1];
                    if (ACT == 1) { f32x2 a = gelu_pk((f32x2){v0[0], v0[1]}), b = gelu_pk((f32x2){v0[2], v0[3]}), c = gelu_pk((f32x2){v1[0], v1[1]}), d = gelu_pk((f32x2){v1[2], v1[3]});
                        v0 = (f32x4){a.x, a.y, b.x, b.y}; v1 = (f32x4){c.x, c.y, d.x, d.y}; }
                    v0 = v0 * sc; v1 = v1 * sc; u32x4 w; w.x = cvt_pk_bf16(v0[0], v0[1]); w.y = cvt_pk_bf16(v0[2], v0[3]); w.z = cvt_pk_bf16(v1[0], v1[1]); w.w = cvt_pk_bf16(v1[2], v1[3]);
                    *(u32x4*)(rowp + bj * HALF) = w; } }
    }
};

__device__ __forceinline__ float bf2f(unsigned short b) { return __uint_as_float((unsigned)b << 16); }
__device__ __forceinline__ float ex2(float x) { return __builtin_amdgcn_exp2f(x); }
__device__ __forceinline__ float fexp(float x) { return __builtin_amdgcn_exp2f(x * 1.4426950408889634f); }
__device__ __forceinline__ float sigm(float x) { return 1.f / (1.f + fexp(-x)); }
__device__ __forceinline__ float silu(float x) { return x / (1.f + fexp(-x)); }
struct EpiResid {
    static constexpr bool PERM = false, AFTER_DRAIN = false;
    const float* xp; const float* xs; float* out; int layer0;
    __device__ __forceinline__ void operator()(const f32x4 (&acc)[2][2][4][2], const Unit& u, int wr, int wc, int fr, int fq) const {
        const int row0 = u.pm * BM + wr * 64 + fr, col0 = u.pn * BM + wc * 32 + 4 * fq;
#pragma unroll
        for (int ai = 0; ai < 2; ++ai)
#pragma unroll
            for (int m = 0; m < 4; ++m) { const int row = row0 + ai * HALF + m * 16;
                if (row < 16512) {
                    const float* src = layer0 ? (row < 16384 ? xp + (size_t)row * 1024 : xs + (size_t)(row - 16384) * 1024) : out + (size_t)row * 1024;
                    float* dst = out + (size_t)row * 1024;
#pragma unroll
                    for (int bj = 0; bj < 2; ++bj)
#pragma unroll
                        for (int n = 0; n < 2; ++n) { const int c = col0 + bj * HALF + n * 16; *(f32x4*)(dst + c) = *(const f32x4*)(src + c) + acc[ai][bj][m][n]; }
                }
                asm volatile("" ::: "memory"); }
    }
};
struct EpiGlu {
    static constexpr bool PERM = true, AFTER_DRAIN = false;
    const bf16_t* GY; const bf16_t* PROJ; bf16_t* MIXED; const float* bias;
    __device__ __forceinline__ void operator()(const f32x4 (&acc)[2][2][4][2], const Unit& u, int wr, int wc, int fr, int fq) const {
        const unsigned row0 = u.pm * BM + wr * 64 + fr, col0 = wc * 32 + 8 * fq;
        const char* gyb = (const char*)GY; const char* pjb = (const char*)PROJ; char* mxb = (char*)MIXED;
#pragma unroll
        for (int bj = 0; bj < 2; ++bj) { const unsigned c = col0 + bj * HALF;
            const f32x4 b0 = *(const f32x4*)(bias + c), b1 = *(const f32x4*)(bias + c + 4);
#pragma unroll
            for (int ai = 0; ai < 2; ++ai)
#pragma unroll
                for (int m = 0; m < 4; ++m) { const unsigned row = row0 + ai * HALF + m * 16;
                    const f32x4 z0 = acc[ai][bj][m][0] + b0, z1 = acc[ai][bj][m][1] + b1;
                    const u32x4 g = *(const u32x4*)(gyb + (row * 256u + c) * 2u), s = *(const u32x4*)(pjb + (row * 3328u + 2304u + c) * 2u);
                    float o[8];
#pragma unroll
                    for (int i = 0; i < 4; ++i) {
                        const float gl = __uint_as_float(g[i] << 16), gh = __uint_as_float(g[i] & 0xffff0000u), sl = __uint_as_float(s[i] << 16), sh = __uint_as_float(s[i] & 0xffff0000u);
                        const float zl = (2 * i < 4) ? z0[(2 * i) & 3] : z1[(2 * i) & 3], zh = (2 * i + 1 < 4) ? z0[(2 * i + 1) & 3] : z1[(2 * i + 1) & 3];
                        o[2 * i] = gl * sigm(zl) * silu(sl); o[2 * i + 1] = gh * sigm(zh) * silu(sh); }
                    u32x4 w; w.x = cvt_pk_bf16(o[0], o[1]); w.y = cvt_pk_bf16(o[2], o[3]); w.z = cvt_pk_bf16(o[4], o[5]); w.w = cvt_pk_bf16(o[6], o[7]);
                    *(u32x4*)(mxb + (row * 1024u + 512u + c) * 2u) = w;
                    asm volatile("" ::: "memory"); } }
    }
};
template <class Epi, class Sched, bool ALIGN_EPI = false, bool SP2 = false>
__device__ __forceinline__ void gemm_phase(PG8_LAS unsigned char* lds, const Gemm g, const Sched& S, const Epi& E, const int tid) {
    const int wid = __builtin_amdgcn_readfirstlane(tid >> 6), lane = tid & 63, wr = wid >> 2, wc = wid & 3, fr = lane & 15, fq = lane >> 4;
    const int K = g.K, nt = K / BK;
    unsigned voffA[2], voffB[2];
#pragma unroll
    for (int i = 0; i < 2; ++i) { int R, C; stage_rc(tid * 16 + i * 8192, R, C); const int Rb = Epi::PERM ? ((R & ~31) + perm32(R & 31)) : R;
        voffA[i] = (unsigned)(R * K + C) * 2u; voffB[i] = (unsigned)(Rb * K + C) * 2u; }
    const size_t kstep = (size_t)(BK * 2);
    const size_t hstep = (size_t)HALF * K * 2;
    const size_t tstep = 2 * hstep;
    const unsigned ldsw = (unsigned)wid * 1024u;
    const int aoff = lds_byte(wr * 64 + fr, fq * 8), boff = lds_byte(wc * 32 + fr, fq * 8);
#define PG8_SA(b, h) (((b) * 2 + (h)) * HTB)
#define PG8_SB(b, h) ((4 + (b) * 2 + (h)) * HTB)
#define PG8_STAGE(bufoff, gbase, voff) do { _Pragma("unroll") for (int _i = 0; _i < 2; ++_i) \
        __builtin_amdgcn_global_load_lds((const unsigned*)((const char*)(gbase) + (voff)[_i]), (PG8_LAS unsigned*)(lds + (bufoff) + ldsw + _i * 8192), 16, 0, 0); } while (0)
#define PG8_LDA(dst, b, h) do { _Pragma("unroll") for (int m = 0; m < 4; ++m) _Pragma("unroll") for (int k = 0; k < 2; ++k) dst[m][k] = *(const PG8_LAS bf16x8*)(lds + PG8_SA(b, h) + aoff + m * 2048 + k * 1024); } while (0)
#define PG8_LDB(dst, b, h) do { _Pragma("unroll") for (int n = 0; n < 2; ++n) _Pragma("unroll") for (int k = 0; k < 2; ++k) dst[n][k] = *(const PG8_LAS bf16x8*)(lds + PG8_SB(b, h) + boff + n * 2048 + k * 1024); } while (0)
#define PG8_MMA(ai, bj, At, Bt) do { __builtin_amdgcn_s_setprio(1); _Pragma("unroll") for (int m = 0; m < 4; ++m) _Pragma("unroll") for (int n = 0; n < 2; ++n) _Pragma("unroll") for (int k = 0; k < 2; ++k) \
        acc[ai][bj][m][n] = __builtin_amdgcn_mfma_f32_16x16x32_bf16(Bt[n][k], At[m][k], acc[ai][bj][m][n], 0, 0, 0); __builtin_amdgcn_s_setprio(0); } while (0)
#define PG8_WAIT_V(n) asm volatile("s_waitcnt vmcnt(" #n ")" ::: "memory")
#define PG8_WAIT_L(n) asm volatile("s_waitcnt lgkmcnt(" #n ")" ::: "memory")
#define PG8_BAR __builtin_amdgcn_s_barrier()
#define PG8_SCHED __builtin_amdgcn_sched_barrier(0)
    Unit cur, nxt; int ui = 0;
    if (!S.next(0, cur)) return;
    f32x4 acc[2][2][4][2];
#pragma unroll
    for (int a = 0; a < 2; ++a)
#pragma unroll
        for (int b = 0; b < 2; ++b)
#pragma unroll
            for (int m = 0; m < 4; ++m)
#pragma unroll
                for (int n = 0; n < 2; ++n) acc[a][b][m][n] = (f32x4){0.f, 0.f, 0.f, 0.f};
    bf16x8 At[4][2], B0[2][2], B1[2][2];
    const char* cA = (const char*)g.A + (size_t)cur.pm * tstep; const char* cB = (const char*)g.Bt + (size_t)cur.pn * tstep;
    S.a_ready(cur);
    if constexpr (SP2) {
        PG8_STAGE(PG8_SB(0, 0), cB, voffB); PG8_STAGE(PG8_SB(0, 1), cB + hstep, voffB); PG8_STAGE(PG8_SA(0, 0), cA, voffA); PG8_STAGE(PG8_SA(0, 1), cA + hstep, voffA);
        if (wr == 1) PG8_BAR;
        PG8_WAIT_V(2); PG8_BAR;
        PG8_STAGE(PG8_SB(1, 0), cB + kstep, voffB); PG8_STAGE(PG8_SA(1, 0), cA + kstep, voffA); PG8_STAGE(PG8_SB(1, 1), cB + hstep + kstep, voffB);
        PG8_WAIT_V(6); PG8_BAR;
    } else {
        PG8_STAGE(PG8_SB(0, 0), cB, voffB); PG8_STAGE(PG8_SA(0, 0), cA, voffA); PG8_STAGE(PG8_SB(0, 1), cB + hstep, voffB); PG8_STAGE(PG8_SA(0, 1), cA + hstep, voffA);
        if (wr == 1) PG8_BAR;
        PG8_WAIT_V(4); PG8_BAR;
        PG8_STAGE(PG8_SB(1, 0), cB + kstep, voffB); PG8_STAGE(PG8_SA(1, 0), cA + kstep, voffA); PG8_STAGE(PG8_SB(1, 1), cB + hstep + kstep, voffB);
        PG8_WAIT_V(6); PG8_BAR;
    }
    for (;;) {
        const bool has_next = S.next(ui + 1, nxt);
        const char* nA = has_next ? (const char*)g.A + (size_t)nxt.pm * tstep : cA; const char* nB = has_next ? (const char*)g.Bt + (size_t)nxt.pn * tstep : cB;
        for (int t = 0; t < nt; t += 2) {
            const bool last = (t == nt - 2);
            const char* a1 = cA + (size_t)(t + 1) * kstep;
            const char* a2 = last ? nA : cA + (size_t)(t + 2) * kstep; const char* b2 = last ? nB : cB + (size_t)(t + 2) * kstep;
            const char* a3 = a2 + kstep; const char* b3 = b2 + kstep;
            if (last && has_next) S.a_ready(nxt);
            if constexpr (SP2) {
            PG8_LDB(B0, 0, 0); PG8_LDB(B1, 0, 1); PG8_SCHED; PG8_LDA(At, 0, 0); PG8_STAGE(PG8_SA(1, 1), a1 + hstep, voffA);
            PG8_WAIT_V(8); PG8_WAIT_L(0); PG8_BAR; PG8_MMA(0, 0, At, B0); PG8_MMA(0, 1, At, B1); PG8_BAR; PG8_SCHED;
            PG8_LDA(At, 0, 1); PG8_STAGE(PG8_SB(0, 0), b2, voffB); PG8_STAGE(PG8_SB(0, 1), b2 + hstep, voffB); PG8_STAGE(PG8_SA(0, 0), a2, voffA);
            PG8_WAIT_V(8); PG8_WAIT_L(0); PG8_BAR; PG8_MMA(1, 0, At, B0); PG8_MMA(1, 1, At, B1); PG8_BAR; PG8_SCHED;
            PG8_LDB(B0, 1, 0); PG8_LDB(B1, 1, 1); PG8_SCHED; PG8_LDA(At, 1, 0); PG8_STAGE(PG8_SA(0, 1), a2 + hstep, voffA);
            PG8_WAIT_V(8); PG8_WAIT_L(0); PG8_BAR; PG8_MMA(0, 0, At, B0); PG8_MMA(0, 1, At, B1); PG8_BAR; PG8_SCHED;
            PG8_LDA(At, 1, 1); PG8_STAGE(PG8_SB(1, 0), b3, voffB); PG8_STAGE(PG8_SB(1, 1), b3 + hstep, voffB); PG8_STAGE(PG8_SA(1, 0), a3, voffA);
            PG8_WAIT_V(8); PG8_WAIT_L(0); PG8_BAR; PG8_MMA(1, 0, At, B0); PG8_MMA(1, 1, At, B1); PG8_BAR; PG8_SCHED;
            } else {
            PG8_LDB(B0, 0, 0); PG8_SCHED; PG8_LDA(At, 0, 0); PG8_STAGE(PG8_SA(1, 1), a1 + hstep, voffA);
            PG8_WAIT_L(8); PG8_BAR; PG8_WAIT_L(0); PG8_MMA(0, 0, At, B0); PG8_BAR; PG8_SCHED;
            PG8_LDB(B1, 0, 1); PG8_STAGE(PG8_SB(0, 0), b2, voffB);
            PG8_BAR; PG8_WAIT_L(0); PG8_MMA(0, 1, At, B1); PG8_BAR;
            PG8_LDA(At, 0, 1); PG8_STAGE(PG8_SA(0, 0), a2, voffA);
            PG8_BAR; PG8_WAIT_L(0); PG8_MMA(1, 0, At, B0); PG8_BAR; PG8_SCHED;
            PG8_STAGE(PG8_SB(0, 1), b2 + hstep, voffB);
            PG8_WAIT_V(6); PG8_BAR; PG8_MMA(1, 1, At, B1); PG8_BAR;
            PG8_LDB(B0, 1, 0); PG8_SCHED; PG8_LDA(At, 1, 0); PG8_STAGE(PG8_SA(0, 1), a2 + hstep, voffA);
            PG8_WAIT_L(8); PG8_BAR; PG8_WAIT_L(0); PG8_MMA(0, 0, At, B0); PG8_BAR; PG8_SCHED;
            PG8_LDB(B1, 1, 1); PG8_STAGE(PG8_SB(1, 0), b3, voffB);
            PG8_BAR; PG8_WAIT_L(0); PG8_MMA(0, 1, At, B1); PG8_BAR;
            PG8_LDA(At, 1, 1); PG8_STAGE(PG8_SA(1, 0), a3, voffA);
            PG8_BAR; PG8_WAIT_L(0); PG8_MMA(1, 0, At, B0); PG8_BAR; PG8_SCHED;
            PG8_STAGE(PG8_SB(1, 1), b3 + hstep, voffB);
            PG8_WAIT_V(6); PG8_BAR; PG8_MMA(1, 1, At, B1); PG8_BAR;
            }
        }
        if constexpr (ALIGN_EPI) { if (wr == 0) PG8_BAR; }
        if constexpr (!Epi::AFTER_DRAIN) { E(acc, cur, wr, wc, fr, fq); S.done(cur); }
        if (!has_next) break;
#pragma unroll
        for (int a = 0; a < 2; ++a)
#pragma unroll
            for (int b = 0; b < 2; ++b)
#pragma unroll
                for (int m = 0; m < 4; ++m)
#pragma unroll
                    for (int n = 0; n < 2; ++n) acc[a][b][m][n] = (f32x4){0.f, 0.f, 0.f, 0.f};
        cur = nxt; cA = nA; cB = nB; ++ui;
        if constexpr (ALIGN_EPI) { if (wr == 1) PG8_BAR; }
    }
    PG8_WAIT_V(0);
    if constexpr (!ALIGN_EPI) { if (wr == 0) PG8_BAR; }
    PG8_BAR;
    if constexpr (Epi::AFTER_DRAIN) { E.fused(acc, cur, wr, wc, fr, fq, lds, wid, lane); S.done(cur); }
#undef PG8_SA
#undef PG8_SB
#undef PG8_STAGE
#undef PG8_LDA
#undef PG8_LDB
#undef PG8_MMA
#undef PG8_WAIT_V
#undef PG8_WAIT_L
#undef PG8_BAR
#undef PG8_SCHED
}
}

constexpr int NWAVES = 8, NTHR = 512;
#ifndef MK_N_LAUNCHES
#define MK_N_LAUNCHES 1
#endif
constexpr int N_PHASES = 15;
constexpr int DM = 1024, MPROMPT = 16384, MSAMP = 128, MVALID = 16512, MPAD = 16640, SEQL = 2048, NB = 8;
constexpr int NPROJ = 3328, NPROJ_FULL = 3332;
constexpr float EPS = 1e-6f;
constexpr size_t O_Y = 0, O_PRET = 16908288, O_PHGRN = 17170432, O_PS5R = 17432576, O_PS5I = 17448960, O_PM2 = 17465344, O_PCONV = 17727488,
                 O_SRET = 17752064, O_SHGRN = 21946368, O_SS5R = 26140672, O_SS5I = 26402816, O_SM2 = 26664960, O_SCONV = 30859264, O_TOTAL = 31252480;
constexpr size_t MiB = 1u << 20;
constexpr size_t WS_CTL = 0, CTL_ZERO_BYTES = 1 * MiB;
constexpr size_t WS_WINT = 2 * MiB;
constexpr size_t WS_WOUTT = 15 * MiB;
constexpr size_t WS_WGLUT = 19 * MiB;
constexpr size_t WS_ROTC = 19 * MiB + 512 * 1024;
constexpr size_t WS_ROTS = 20 * MiB;
constexpr size_t WS_S5AB = 20 * MiB + 512 * 1024;
constexpr size_t WS_S5BB = 20 * MiB + 768 * 1024;
constexpr size_t WS_LB = 21 * MiB + 512 * 1024;
constexpr size_t WS_DT = 22 * MiB;
constexpr size_t WS_MSQ = 22 * MiB + 512 * 1024;
constexpr size_t WS_XB = 24 * MiB;
constexpr size_t WS_MIXED = 57 * MiB;
constexpr size_t WS_GY = 90 * MiB;
constexpr size_t WS_PROJ = 100 * MiB;
constexpr size_t WS_ZB = 206 * MiB;
constexpr size_t WS_END = 256 * MiB;
constexpr int CW_BAR = 4096;
constexpr int RING_OFF = 0, RING_BYTES = 131072;
constexpr int LDS_BYTES = 163840;
constexpr int LDSCTL_OFF = LDS_BYTES - 512, MISC_OFF = LDSCTL_OFF + 320;

#define GAS __attribute__((address_space(1)))
#define LAS __attribute__((address_space(3)))
#define DI __device__ __forceinline__
typedef unsigned short bf16;
typedef unsigned v4u __attribute__((ext_vector_type(4)));
typedef unsigned v2u __attribute__((ext_vector_type(2)));
typedef float f32x4 __attribute__((ext_vector_type(4)));
typedef GAS unsigned gu32;
#define RLX_AGENT __ATOMIC_RELAXED, __HIP_MEMORY_SCOPE_AGENT
#define LDS_WAIT() asm volatile("s_waitcnt lgkmcnt(0)" ::: "memory")
#define VM_WAIT() asm volatile("s_waitcnt vmcnt(0)" ::: "memory")
DI unsigned f2bf(float f) { unsigned u = __builtin_bit_cast(unsigned, f); return (u + 0x7fffu + ((u >> 16) & 1u)) >> 16; }
DI unsigned pk2(float lo, float hi) { return f2bf(lo) | (f2bf(hi) << 16); }
using pg8::bf2f; using pg8::ex2; using pg8::fexp; using pg8::sigm; using pg8::silu;

#define XB_TMO      128
#define XB_XCNT(j)  (256  + 64 * (j))
#define XB_XSUB(j)  (1280 + 64 * (j))
#define XB_XGEN(j)  (2304 + 64 * (j))
#define XB_TOP      3328
#define XB_TOPGEN   3392
#define XCD_BAR_WORDS 3456
#define XB_SPIN_CAP (1u << 18)

__device__ __forceinline__ unsigned xb_ld(unsigned* p)              { return __hip_atomic_load(p, __ATOMIC_RELAXED, __HIP_MEMORY_SCOPE_AGENT); }
__device__ __forceinline__ unsigned xb_add(unsigned* p, unsigned v) { return __hip_atomic_fetch_add(p, v, __ATOMIC_RELAXED, __HIP_MEMORY_SCOPE_AGENT); }
__device__ __forceinline__ unsigned xb_xcc_id() { return (unsigned)__builtin_amdgcn_s_getreg((3 << 11) | 20) & 0xFu; }
#define XB_SPIN(cond, bar) do { unsigned _sp = 0; while (cond) { __builtin_amdgcn_s_sleep(1); \
    if ((++_sp & 255u) == 0u) { if (xb_ld(&(bar)[XB_TMO])) break; if (_sp > XB_SPIN_CAP) { atomicAdd(&(bar)[XB_TMO], 1u); break; } } } } while (0)

struct XcdBarrier {
    unsigned* bar; unsigned x;
    volatile LAS unsigned* st;
};

__device__ __forceinline__ XcdBarrier xcd_barrier_post(unsigned* bar, volatile LAS unsigned* st) {
    XcdBarrier b; b.bar = bar; b.x = xb_xcc_id(); b.st = st;
    if (threadIdx.x == 0) (void)xb_add(&bar[XB_XCNT(b.x)], 1u);
    return b;
}
__device__ __forceinline__ void xcd_barrier_complete(unsigned* bar, unsigned x, unsigned& nloc, unsigned& nx) {
    const unsigned G = gridDim.x * gridDim.y * gridDim.z;
    unsigned sum, cnt, mine, sp = 0u;
    for (;;) {
        sum = 0u; cnt = 0u; mine = 0u;
#pragma unroll
        for (unsigned j = 0; j < 16; ++j) { const unsigned c = xb_ld(&bar[XB_XCNT(j)]); sum += c; cnt += (c > 0u) ? 1u : 0u; mine = (j == x) ? c : mine; }
        if (sum == G) break;
        __builtin_amdgcn_s_sleep(1);
        if ((++sp & 255u) == 0u) { if (xb_ld(&bar[XB_TMO])) break; if (sp > XB_SPIN_CAP) { atomicAdd(&bar[XB_TMO], 1u); break; } }
    }
    nloc = mine > 0u ? mine : 1u; nx = cnt > 0u ? cnt : 1u;
}

__device__ __forceinline__ void xcd_barrier(const XcdBarrier& b) {
    asm volatile("s_waitcnt vmcnt(0)" ::: "memory");
    __syncthreads();
    if (threadIdx.x == 0) {
        unsigned* bar = b.bar;
        __builtin_amdgcn_s_waitcnt(0);
        unsigned nloc = b.st[0], nx = b.st[1];
        if (nloc == 0u) { xcd_barrier_complete(bar, b.x, nloc, nx); b.st[0] = nloc; b.st[1] = nx; }
        const unsigned old = xb_add(&bar[XB_XSUB(b.x)], 1u);
        const unsigned gen = old / nloc;
        if (old + 1u == (gen + 1u) * nloc) {
            __builtin_amdgcn_fence(__ATOMIC_RELEASE, "agent");
            asm volatile("s_waitcnt vmcnt(0)" ::: "memory");
            const unsigned og = xb_add(&bar[XB_TOP], 1u);
            const unsigned tg = og / nx;
            if (og + 1u == (tg + 1u) * nx) xb_add(&bar[XB_TOPGEN], 1u);
            else XB_SPIN(xb_ld(&bar[XB_TOPGEN]) == tg, bar);
            __builtin_amdgcn_fence(__ATOMIC_ACQUIRE, "agent");
            xb_add(&bar[XB_XGEN(b.x)], 1u);
            asm volatile("s_waitcnt vmcnt(0)" ::: "memory");
        } else {
            XB_SPIN(xb_ld(&bar[XB_XGEN(b.x)]) == gen, bar);
            __builtin_amdgcn_fence(__ATOMIC_ACQUIRE, "agent");
            asm volatile("s_waitcnt vmcnt(0)" ::: "memory");
        }
    }
    __syncthreads();
}

struct Args { const float* in[31]; float* out; unsigned char* ws; int ph_lo, ph_hi, li, pad; };
struct Frame {
    LAS unsigned char* lds; volatile LAS unsigned* MISC; gu32* ctl;
    int tid, lane, wave, vcu, G, bx;
    const float* const* ka; float* out_; unsigned char* ws_;
};
DI const float* INP(const Frame& F, int i) { const float* const* t = F.ka; asm volatile("" : "+s"(t)); return t[i]; }
DI unsigned char* WSP(const Frame& F) { unsigned char* w = F.ws_; asm volatile("" : "+s"(w)); return w; }
DI float* OUTP(const Frame& F) { float* o = F.out_; asm volatile("" : "+s"(o)); return o; }
DI float wave_sum(float v) {
#pragma unroll
    for (int o = 1; o < 64; o <<= 1) v += __shfl_xor(v, o);
    return v;
}
DI void sincos_acc(float ang, float& s, float& c) {
    const float C1 = 0.15915493667125702f, C2 = 6.4206382432985265e-09f;
    const float hi = ang * C1, lo = __builtin_fmaf(ang, C1, -hi) + ang * C2;
    const float f = (hi - __builtin_rintf(hi)) + lo;
    const float qf = __builtin_rintf(4.f * f); const int q = (int)qf;
    const float u = __builtin_fmaf(-0.25f, qf, f);
    const float r = __builtin_fmaf(u, 6.2831854820251465f, u * -1.7484555314695172e-07f);
    const float r2 = r * r;
    float sp = 2.7557319e-06f; sp = __builtin_fmaf(sp, r2, -1.9841270e-04f); sp = __builtin_fmaf(sp, r2, 8.3333333e-03f); sp = __builtin_fmaf(sp, r2, -1.6666667e-01f);
    const float sn = __builtin_fmaf(r * r2, sp, r);
    float cp = -2.7557319e-07f; cp = __builtin_fmaf(cp, r2, 2.4801587e-05f); cp = __builtin_fmaf(cp, r2, -1.3888889e-03f); cp = __builtin_fmaf(cp, r2, 4.1666667e-02f); cp = __builtin_fmaf(cp, r2, -0.5f);
    const float cs = __builtin_fmaf(r2, cp, 1.f);
    const int qq = q & 3;
    s = qq == 0 ? sn : qq == 1 ? cs : qq == 2 ? -sn : -cs;
    c = qq == 0 ? cs : qq == 1 ? -sn : qq == 2 ? -cs : sn;
}
__device__ __constant__ float ROT_INV[32] = {1.000000000e+00f, 7.498942018e-01f, 5.623413324e-01f, 4.216965139e-01f, 3.162277639e-01f, 2.371373773e-01f, 1.778279394e-01f, 1.333521456e-01f, 1.000000015e-01f, 7.498942316e-02f, 5.623413250e-02f, 4.216964915e-02f, 3.162277490e-02f, 2.371373773e-02f, 1.778279431e-02f, 1.333521400e-02f, 9.999999776e-03f, 7.498942316e-03f, 5.623413250e-03f, 4.216964822e-03f, 3.162277630e-03f, 2.371373819e-03f, 1.778279431e-03f, 1.333521446e-03f, 1.000000047e-03f, 7.498941850e-04f, 5.623413017e-04f, 4.216965172e-04f, 3.162277571e-04f, 2.371373703e-04f, 1.778279402e-04f, 1.333521504e-04f};
DI void transpose_item(const float* W, int K, int ld, int nblk, bf16* WT, LAS float* scr, int item, int lane) {
    const int kb = item / nblk, nb = item % nblk, k0 = 64 * kb, n0 = 32 * nb;
#pragma unroll 8
    for (int i = 0; i < 32; ++i) { const int kk = 2 * i + (lane >> 5); scr[kk * 33 + (lane & 31)] = W[(size_t)(k0 + kk) * ld + n0 + (lane & 31)]; }
    LDS_WAIT(); asm volatile("" ::: "memory");
    const int c = lane & 7;
#pragma unroll
    for (int j = 0; j < 4; ++j) { const int n = (lane >> 3) + 8 * j; const LAS float* s = scr + (8 * c) * 33 + n;
        v4u o; o.x = pk2(s[0 * 33], s[1 * 33]); o.y = pk2(s[2 * 33], s[3 * 33]); o.z = pk2(s[4 * 33], s[5 * 33]); o.w = pk2(s[6 * 33], s[7 * 33]);
        *(GAS v4u*)(WT + (size_t)(n0 + n) * K + k0 + 8 * c) = o; }
    LDS_WAIT(); asm volatile("" ::: "memory");
}
DI void aprep(Frame& F, int layer) {
    LAS f32x4* wdt = (LAS f32x4*)(F.lds + RING_OFF);
    const float* Win = INP(F, 9) + (size_t)layer * DM * NPROJ_FULL;
    for (int k = F.tid; k < DM; k += NTHR) wdt[k] = *(const f32x4*)(Win + (size_t)k * NPROJ_FULL + NPROJ);
    __syncthreads();
    const float* nw = INP(F, 8) + layer * DM;
    bf16* XB = (bf16*)(WSP(F) + WS_XB); float* DT = (float*)(WSP(F) + WS_DT);
    const int gw = F.vcu * NWAVES + F.wave, NGW = F.G * NWAVES, lane = F.lane;
    f32x4 nwv[4];
#pragma unroll
    for (int j = 0; j < 4; ++j) nwv[j] = *((const f32x4*)nw + lane + 64 * j);
    for (int m = gw; m < MPAD; m += NGW) {
        GAS unsigned long long* o8 = (GAS unsigned long long*)(XB + (size_t)m * DM) + lane;
        if (m >= MVALID) {
#pragma unroll
            for (int j = 0; j < 4; ++j) o8[64 * j] = 0ull;
            continue; }
        const float* src = layer == 0 ? (m < MPROMPT ? INP(F, 0) + (size_t)m * DM : INP(F, 1) + (size_t)(m - MPROMPT) * DM) : OUTP(F) + (size_t)m * DM;
        const f32x4* xr = (const f32x4*)src + lane;
        f32x4 v[4]; float ss = 0.f;
#pragma unroll
        for (int j = 0; j < 4; ++j) { v[j] = xr[64 * j]; ss += (v[j].x * v[j].x + v[j].y * v[j].y) + (v[j].z * v[j].z + v[j].w * v[j].w); }
        const float rstd = 1.f / sqrtf(wave_sum(ss) * (1.f / DM) + EPS);
        f32x4 d = (f32x4){0.f, 0.f, 0.f, 0.f};
#pragma unroll
        for (int j = 0; j < 4; ++j) { v[j] = v[j] * rstd * nwv[j];
            const int k = 4 * (lane + 64 * j);
            d += wdt[k] * v[j].x; d += wdt[k + 1] * v[j].y; d += wdt[k + 2] * v[j].z; d += wdt[k + 3] * v[j].w;
            o8[64 * j] = (unsigned long long)pk2(v[j].x, v[j].y) | ((unsigned long long)pk2(v[j].z, v[j].w) << 32); }
        d.x = wave_sum(d.x); d.y = wave_sum(d.y); d.z = wave_sum(d.z); d.w = wave_sum(d.w);
        if (lane == 0) *(f32x4*)(DT + (size_t)m * 4) = d;
    }
}
DI void final_norm(Frame& F) {
    const float* fw = INP(F, 30);
    const int gw = F.vcu * NWAVES + F.wave, NGW = F.G * NWAVES, lane = F.lane;
    f32x4 nwv[4];
#pragma unroll
    for (int j = 0; j < 4; ++j) nwv[j] = *((const f32x4*)fw + lane + 64 * j);
    for (int m = gw; m < MVALID; m += NGW) {
        f32x4* xr = (f32x4*)(OUTP(F) + (size_t)m * DM) + lane;
        f32x4 v[4]; float ss = 0.f;
#pragma unroll
        for (int j = 0; j < 4; ++j) { v[j] = xr[64 * j]; ss += (v[j].x * v[j].x + v[j].y * v[j].y) + (v[j].z * v[j].z + v[j].w * v[j].w); }
        const float rstd = 1.f / sqrtf(wave_sum(ss) * (1.f / DM) + EPS);
#pragma unroll
        for (int j = 0; j < 4; ++j) xr[64 * j] = v[j] * rstd * nwv[j];
    }
}
DI void prologue(Frame& F) {
    LAS float* scr = (LAS float*)(F.lds + RING_OFF + 16384 + F.wave * 12288);
    const int gw = F.vcu * NWAVES + F.wave, NGW = F.G * NWAVES;
    constexpr int I_IN = 16 * 104, I_OUT = 16 * 32, I_GLU = 4 * 8, I_L = I_IN + I_OUT + I_GLU;
    for (int it = gw; it < 2 * I_L; it += NGW) {
        const int l = it / I_L; int r = it % I_L;
        if (r < I_IN) { transpose_item(INP(F, 9) + (size_t)l * DM * NPROJ_FULL, DM, NPROJ_FULL, 104, (bf16*)(WSP(F) + WS_WINT) + (size_t)l * NPROJ * DM, scr, r, F.lane); continue; } r -= I_IN;
        if (r < I_OUT) { transpose_item(INP(F, 29) + (size_t)l * DM * DM, DM, DM, 32, (bf16*)(WSP(F) + WS_WOUTT) + (size_t)l * DM * DM, scr, r, F.lane); continue; } r -= I_OUT;
        transpose_item(INP(F, 21) + (size_t)l * 65536, 256, 256, 8, (bf16*)(WSP(F) + WS_WGLUT) + (size_t)l * 65536, scr, r, F.lane);
    }
    const int gt = F.vcu * NTHR + F.tid, NGT = F.G * NTHR;
    float* RC = (float*)(WSP(F) + WS_ROTC); float* RS = (float*)(WSP(F) + WS_ROTS);
    for (int idx = gt; idx < 2049 * 32; idx += NGT) {
        const int p = idx >> 5, i = idx & 31; const float pos = p < 2048 ? (float)p : 16384.f;
        const float ang = pos * ROT_INV[i];
        float s, c; sincos_acc(ang, s, c); RC[idx] = c; RS[idx] = s;
    }
    float* AB = (float*)(WSP(F) + WS_S5AB); float* BB = (float*)(WSP(F) + WS_S5BB);
    for (int idx = gt; idx < 2 * 16 * 64; idx += NGT) {
        const int l = idx >> 10, g = (idx >> 6) & 15;
        const float are = INP(F, 13)[idx], aim = INP(F, 14)[idx], dt = expf(INP(F, 15)[l * 16 + g]);
        const float mag = expf(are * dt); float s, c; sincos_acc(aim * dt, s, c);
        const float abr = mag * c, abi = mag * s; AB[2 * idx] = abr; AB[2 * idx + 1] = abi;
        const float nr = abr - 1.f, ni = abi, den = are * are + aim * aim;
        const float fr = (nr * are + ni * aim) / den, fi = (ni * are - nr * aim) / den;
        for (int cc = 0; cc < 16; ++cc) { const float br = INP(F, 16)[(size_t)idx * 16 + cc], bi = INP(F, 17)[(size_t)idx * 16 + cc];
            BB[((size_t)idx * 16 + cc) * 2] = fr * br - fi * bi; BB[((size_t)idx * 16 + cc) * 2 + 1] = fr * bi + fi * br; }
    }
    float* LB = (float*)(WSP(F) + WS_LB);
    for (int idx = gt; idx < 256; idx += NGT) {
        const float l0 = INP(F, 11)[idx], l1 = INP(F, 11)[256 + idx], mx = fmaxf(l0, l1), e0 = expf(l0 - mx), e1 = expf(l1 - mx);
        const float s0 = e0 / (e0 + e1), s1 = e1 / (e0 + e1);
        LB[idx] = fminf(fmaxf(s0 - s0, 0.f), 1.f); LB[256 + idx] = fminf(fmaxf((s0 + s1) - s0, 0.f), 1.f);
    }
    __syncthreads();
    aprep(F, 0);
}
DI float gelu_tanh(float x) { const float u = 0.7978845608028654f * (x + 0.044715f * x * x * x); const float t = 1.f - 2.f / (1.f + fexp(2.f * u)); return 0.5f * x * (1.f + t); }
DI float softplus(float x) { return fmaxf(x, 0.f) + log1pf(expf(-fabsf(x))); }
DI void linrec_unit(Frame& F, int layer, int branch, int h, int row0, int ntok, int rot0, const float* h0, float* hout, const float* cb0, float* cbout) {
    LAS float* Q = (LAS float*)(F.lds + RING_OFF); LAS float* K = Q + 4096; LAS float* V = K + 4096; LAS float* A = V + 4096; LAS float* O = A + 4096; LAS float* Gt = O + 4096; LAS float* X = Gt + 4096;
    const bf16* P = (const bf16*)(WSP(F) + WS_PROJ); bf16* MX = (bf16*)(WSP(F) + WS_MIXED);
    const float* RC = (const float*)(WSP(F) + WS_ROTC); const float* RS = (const float*)(WSP(F) + WS_ROTS); const float* LB = (const float*)(WSP(F) + WS_LB) + layer * 256;
    const float* DT = (const float*)(WSP(F) + WS_DT); float* MSQ = (float*)(WSP(F) + WS_MSQ);
    int tid_ = F.tid; asm volatile("" : "+v"(tid_));
    const int tid = tid_, w = __builtin_amdgcn_readfirstlane(tid >> 6), lane = tid & 63, vi = lane & 7, kg = lane >> 3, v = 8 * w + vi;
    float hs[8];
#pragma unroll
    for (int j = 0; j < 8; ++j) hs[j] = h0 ? h0[(8 * kg + j) * 64 + v] : 0.f;
    const float gamma = 1.f - ex2(-5.f - (float)h);
    const float* cw = INP(F, 23) + layer * 2048; const float* cbias = INP(F, 24) + layer * 512;
    const float dtb = INP(F, 25)[layer * 4 + h], Ah = -expf(INP(F, 26)[layer * 4 + h]), Dh = INP(F, 27)[layer * 4 + h];
    const int g2 = h >> 1;
    for (int c0 = 0; c0 < ntok; c0 += 64) {
        const int nt = (ntok - c0) < 64 ? (ntok - c0) : 64;
        __syncthreads();
        for (int e = tid; e < 4096; e += NTHR) {
            const int t = e >> 6, ch = e & 63; if (t >= nt) continue;
            const size_t r = (size_t)(row0 + c0 + t); const bf16* pr = P + r * NPROJ;
            if (branch == 0) {
                const int i = ch & 31; const float cs = RC[(rot0 + c0 + t) * 32 + i], sn = RS[(rot0 + c0 + t) * 32 + i];
                const float q1 = bf2f(pr[h * 64 + i]), q2 = bf2f(pr[h * 64 + 32 + i]), k1 = bf2f(pr[256 + h * 64 + i]), k2 = bf2f(pr[256 + h * 64 + 32 + i]);
                Q[e] = ch < 32 ? q1 * cs - q2 * sn : q1 * sn + q2 * cs;
                K[e] = (ch < 32 ? k1 * cs - k2 * sn : k1 * sn + k2 * cs) * 0.125f;
                V[e] = bf2f(pr[512 + h * 64 + ch]); A[e] = gamma; Gt[e] = bf2f(pr[768 + h * 64 + ch]);
            } else if (branch == 1) {
                const float fr = bf2f(pr[1280 + h * 64 + ch]), lb = LB[h * 64 + ch], sg = sigm(fr);
                Q[e] = silu(bf2f(pr[1024 + h * 64 + ch])); A[e] = lb + (1.f - lb) * sg; K[e] = (1.f - lb) * sigm(-fr);
                V[e] = bf2f(pr[1536 + h * 64 + ch]); Gt[e] = bf2f(pr[1792 + h * 64 + ch]);
            } else {
                const int cx = h * 64 + ch, cB = 256 + g2 * 64 + ch, cC = 384 + g2 * 64 + ch;
                float ax = cbias[cx], aB = cbias[cB], aC = cbias[cC];
#pragma unroll
                for (int i = 0; i < 4; ++i) { const int tt = c0 + t - 3 + i; float rx, rB, rC;
                    if (tt >= 0) { const bf16* p2 = P + (size_t)(row0 + tt) * NPROJ + 2816; rx = bf2f(p2[cx]); rB = bf2f(p2[cB]); rC = bf2f(p2[cC]); }
                    else if (cb0) { rx = cb0[(3 + tt) * 512 + cx]; rB = cb0[(3 + tt) * 512 + cB]; rC = cb0[(3 + tt) * 512 + cC]; }
                    else { rx = 0.f; rB = 0.f; rC = 0.f; }
                    ax += cw[i * 512 + cx] * rx; aB += cw[i * 512 + cB] * rB; aC += cw[i * 512 + cC] * rC; }
                const float xc = silu(ax), dt = softplus(DT[r * 4 + h] + dtb);
                Q[e] = silu(aC); K[e] = silu(aB); V[e] = xc * dt; A[e] = expf(dt * Ah); X[e] = xc; Gt[e] = bf2f(pr[2560 + h * 64 + ch]);
            }
        }
        __syncthreads();
        for (int t = 0; t < nt; ++t) {
            const LAS float* q = Q + t * 64 + 8 * kg; const LAS float* k = K + t * 64 + 8 * kg; const LAS float* a = A + t * 64 + 8 * kg; const float vv = V[t * 64 + v];
            float p = 0.f;
#pragma unroll
            for (int j = 0; j < 8; ++j) { hs[j] = a[j] * hs[j] + k[j] * vv; p += q[j] * hs[j]; }
            p += __shfl_xor(p, 8); p += __shfl_xor(p, 16); p += __shfl_xor(p, 32);
            if (kg == 0) O[t * 64 + v] = p;
        }
        __syncthreads();
        {
            const int t = tid >> 3, sub = tid & 7; const size_t r = (size_t)(row0 + c0 + t);
            float o[8]; float ss = 0.f;
#pragma unroll
            for (int j = 0; j < 8; ++j) { const int e = t * 64 + sub * 8 + j; float x = O[e]; if (branch == 2) x = (x + Dh * X[e]) * silu(Gt[e]); o[j] = x; ss += x * x; }
            ss += __shfl_xor(ss, 1); ss += __shfl_xor(ss, 2); ss += __shfl_xor(ss, 4);
            if (t < nt) {
                if (branch != 2) { const float sc = 1.f / sqrtf(ss * (1.f / 64.f) + EPS); const float* nw = INP(F, branch == 0 ? 10 : 12) + layer * 256 + h * 64 + sub * 8;
#pragma unroll
                    for (int j = 0; j < 8; ++j) o[j] = o[j] * sc * nw[j] * silu(Gt[t * 64 + sub * 8 + j]); }
                else if (sub == 0) MSQ[r * 4 + h] = ss;
                v4u wv; wv.x = pk2(o[0], o[1]); wv.y = pk2(o[2], o[3]); wv.z = pk2(o[4], o[5]); wv.w = pk2(o[6], o[7]);
                *(v4u*)(MX + r * DM + branch * 256 + (branch == 2 ? 256 : 0) + h * 64 + sub * 8) = wv;
            }
        }
    }
#pragma unroll
    for (int j = 0; j < 8; ++j) hout[(8 * kg + j) * 64 + v] = hs[j];
    if (branch == 2 && h == 0) {
        for (int e = tid; e < 1536; e += NTHR) { const int i = e / 512, cc = e % 512, tt = ntok - 3 + i;
            cbout[e] = tt >= 0 ? bf2f(P[(size_t)(row0 + tt) * NPROJ + 2816 + cc]) : (cb0 ? cb0[(3 + tt) * 512 + cc] : 0.f); }
    }
}
DI void s5_unit(Frame& F, int layer, int g, int row0, int ntok, const float* h0r, const float* h0i, float* hor, float* hoi) {
    LAS float* U = (LAS float*)(F.lds + RING_OFF); LAS float* H = U + 1024; LAS float* Cr = H + 8192; LAS float* Ci = Cr + 1024;
    const bf16* P = (const bf16*)(WSP(F) + WS_PROJ); bf16* GY = (bf16*)(WSP(F) + WS_GY);
    int tid_ = F.tid; asm volatile("" : "+v"(tid_)); const int tid = tid_;
    __syncthreads();
    for (int e = tid; e < 1024; e += NTHR) { Cr[e] = INP(F, 18)[(size_t)(layer * 16 + g) * 1024 + e]; Ci[e] = INP(F, 19)[(size_t)(layer * 16 + g) * 1024 + e]; }
    float hr = 0.f, hi = 0.f, abr = 0.f, abi = 0.f; float bbr[16], bbi[16];
    if (tid < 64) { const int idx = (layer * 16 + g) * 64 + tid; const float* AB = (const float*)(WSP(F) + WS_S5AB); const float* BB = (const float*)(WSP(F) + WS_S5BB);
        abr = AB[2 * idx]; abi = AB[2 * idx + 1];
#pragma unroll
        for (int c = 0; c < 16; ++c) { bbr[c] = BB[((size_t)idx * 16 + c) * 2]; bbi[c] = BB[((size_t)idx * 16 + c) * 2 + 1]; }
        if (h0r) { hr = h0r[tid]; hi = h0i[tid]; } }
    const float* Dv = INP(F, 20) + layer * 256 + g * 16;
    for (int c0 = 0; c0 < ntok; c0 += 64) {
        const int nt = (ntok - c0) < 64 ? (ntok - c0) : 64;
        __syncthreads();
        for (int e = tid; e < 1024; e += NTHR) { const int t = e >> 4, c = e & 15; if (t < nt) U[e] = bf2f(P[(size_t)(row0 + c0 + t) * NPROJ + 2048 + g * 16 + c]); }
        __syncthreads();
        if (tid < 64) {
            for (int t = 0; t < nt; ++t) {
                float br = 0.f, bi = 0.f;
#pragma unroll
                for (int c = 0; c < 16; ++c) { const float u = U[t * 16 + c]; br += bbr[c] * u; bi += bbi[c] * u; }
                const float nr = abr * hr - abi * hi + br, ni = abr * hi + abi * hr + bi; hr = nr; hi = ni;
                H[(t * 64 + tid) * 2] = hr; H[(t * 64 + tid) * 2 + 1] = hi;
            }
        }
        __syncthreads();
        for (int e = tid; e < 1024; e += NTHR) { const int t = e >> 4, c = e & 15; if (t >= nt) continue;
            float y = 0.f;
            for (int p = 0; p < 64; ++p) y += Cr[c * 64 + p] * H[(t * 64 + p) * 2] - Ci[c * 64 + p] * H[(t * 64 + p) * 2 + 1];
            const float sy = y + Dv[c] * U[e];
            GY[(size_t)(row0 + c0 + t) * 256 + g * 16 + c] = (bf16)f2bf(gelu_tanh(sy)); }
    }
    if (tid < 64) { hor[tid] = hr; hoi[tid] = hi; }
}

typedef short bf16x8 __attribute__((ext_vector_type(8)));
typedef short s16x4 __attribute__((ext_vector_type(4)));
typedef short v4i16_t __attribute__((ext_vector_type(4)));
typedef float f32x16 __attribute__((ext_vector_type(16)));
typedef float f32x2v __attribute__((ext_vector_type(2)));
typedef __bf16 bf16x2v __attribute__((ext_vector_type(2)));
DI unsigned cvtpk(float lo, float hi) { f32x2v v = {lo, hi}; bf16x2v b = __builtin_convertvector(v, bf16x2v); return __builtin_bit_cast(unsigned, b); }
DI int crow(int i, int hh) { return (i & 3) + 8 * (i >> 2) + 4 * hh; }
#define MFMA32(a, b, c) __builtin_amdgcn_mfma_f32_32x32x16_bf16((a), (b), (c), 0, 0, 0)
constexpr int TP = 144, TILE_B = 64 * TP;
constexpr int VEC_OFF = 12 * TILE_B;
DI int toff(int row, int col) { return row * TP + col * 2; }
DI bf16x8 ld128(LAS unsigned char* p) { return *(LAS bf16x8*)p; }
DI s16x4 ld64(LAS unsigned char* p) { return *(LAS s16x4*)p; }
DI s16x4 ldtr(LAS unsigned char* p) { return __builtin_bit_cast(s16x4, __builtin_amdgcn_ds_read_tr16_b64_v4i16((LAS v4i16_t*)p)); }
DI bf16x8 cat8(s16x4 lo, s16x4 hi) { return __builtin_shufflevector(lo, hi, 0, 1, 2, 3, 4, 5, 6, 7); }
template <int ST> DI bf16x8 packacc(const f32x16& x) {
    v4u p; p.x = cvtpk(x[8 * ST], x[8 * ST + 1]); p.y = cvtpk(x[8 * ST + 2], x[8 * ST + 3]); p.z = cvtpk(x[8 * ST + 4], x[8 * ST + 5]); p.w = cvtpk(x[8 * ST + 6], x[8 * ST + 7]);
    return __builtin_bit_cast(bf16x8, p);
}
template <bool PERM> DI bf16x8 trfrag(LAS unsigned char* tile, int R0  , int C0, int lane) {
    const int hh = lane >> 5, q = (lane & 15) >> 2, p = lane & 3, blk = (lane >> 4) & 1;
    const int rlo = PERM ? R0 + 4 * hh + q : R0 + 8 * hh + q, rhi = PERM ? rlo + 8 : rlo + 4;
    const int col = C0 + 16 * blk + 4 * p;
    return cat8(ldtr(tile + toff(rlo, col)), ldtr(tile + toff(rhi, col)));
}
constexpr size_t WS_SLOC = 210 * MiB;
constexpr size_t WS_DTOT = 223 * MiB;
constexpr size_t WS_S5LOC = 224 * MiB;

template <int BR, bool OUT> DI void lin_unit(Frame& F, int l, int pm) {
    LAS unsigned char* L = F.lds;
    unsigned char* ws = WSP(F);
    const bf16* PJ = (const bf16*)(ws + WS_PROJ); bf16* MX = (bf16*)(ws + WS_MIXED);
    float* SLOC = (float*)(ws + WS_SLOC); float* DTOT = (float*)(ws + WS_DTOT);
    int tid_ = F.tid; asm volatile("" : "+v"(tid_));
    const int tid = tid_, lane = tid & 63, wv = __builtin_amdgcn_readfirstlane(tid >> 6), hd = wv >> 1, th = wv & 1, r = lane & 31, hh = lane >> 5;
    const int b = pm >> 3, sc = pm & 7, hid = BR * 4 + hd;
    const size_t row0 = (size_t)pm * 256;
    LAS unsigned char* Qt = L + (BR == 2 ? (2 * (hd >> 1)) : 3 * hd) * TILE_B;
    LAS unsigned char* Kt = L + (BR == 2 ? (2 * (hd >> 1) + 1) : 3 * hd + 1) * TILE_B;
    LAS unsigned char* Vt = L + (BR == 2 ? (4 + 2 * hd) : 3 * hd + 2) * TILE_B;
    LAS unsigned char* Wt = L + (5 + 2 * hd) * TILE_B;
    LAS float* ECM = (LAS float*)(L + VEC_OFF); LAS float* ETL = ECM + 256;
    LAS float* CUM = ETL + 256; LAS float* DTS = CUM + 256; LAS float* DTW = DTS + 256; LAS float* LA = DTW + 256; LAS float* SSQ = LA + 256; LAS float* TOT = SSQ + 256;
    f32x16 H[2][2];
#pragma unroll
    for (int a = 0; a < 2; ++a)
#pragma unroll
        for (int c = 0; c < 2; ++c)
#pragma unroll
            for (int i = 0; i < 16; ++i) H[a][c][i] = 0.f;
#ifndef X_NOINIT
    if (OUT) {
        for (int j = 0; j < sc; ++j) {
            const size_t u = (size_t)((pm - sc + j) * 12 + hid);
#pragma unroll
            for (int ki = 0; ki < 2; ++ki)
#pragma unroll
                for (int i = 0; i < 16; ++i) { const int k = 32 * ki + crow(i, hh); const float d = ex2(DTOT[u * 64 + k]);
#pragma unroll
                    for (int vj = 0; vj < 2; ++vj) H[ki][vj][i] = H[ki][vj][i] * d + SLOC[(u * 64 + k) * 64 + 32 * vj + r];
                    if ((i & 3) == 3) __builtin_amdgcn_sched_barrier(0); }
        }
    }
#endif
    float dsum = 0.f;
    const float lg2 = BR == 0 ? __builtin_amdgcn_logf(1.f - ex2(-5.f - (float)hd)) : 0.f;
#pragma unroll 1
    for (int c = 0; c < 4; ++c) {
        const size_t rowc = row0 + 64 * c;
        if (BR == 0) {
            const int li = th * 64 + lane;
            const float* RC = (const float*)(ws + WS_ROTC); const float* RS = (const float*)(ws + WS_ROTS);
#pragma unroll
            for (int which = 0; which < 2; ++which) {
                if (which == 0 && !OUT) continue;
#pragma unroll
                for (int j = 0; j < 2; ++j) { const int tk = li + 128 * j, t = tk >> 2, c0 = 8 * (tk & 3);
                    const bf16* src = PJ + (rowc + t) * NPROJ + which * 256 + hd * 64 + c0;
                    const v4u xa = *(const v4u*)src, xb = *(const v4u*)(src + 32);
                    const int pos = sc * 256 + c * 64 + t;
                    const f32x4 cs0 = *(const f32x4*)(RC + pos * 32 + c0), cs1 = *(const f32x4*)(RC + pos * 32 + c0 + 4), sn0 = *(const f32x4*)(RS + pos * 32 + c0), sn1 = *(const f32x4*)(RS + pos * 32 + c0 + 4);
                    const float sc_ = which == 0 ? ex2((float)(t - 31) * lg2) : 0.125f * ex2((float)(31 - t) * lg2);
                    float lo[8], hi[8];
#pragma unroll
                    for (int e = 0; e < 8; ++e) { const unsigned wa = xa[e >> 1], wb = xb[e >> 1]; const float a = (e & 1) ? __uint_as_float(wa & 0xffff0000u) : __uint_as_float(wa << 16), bb = (e & 1) ? __uint_as_float(wb & 0xffff0000u) : __uint_as_float(wb << 16);
                        const float cs = e < 4 ? cs0[e & 3] : cs1[e & 3], sn = e < 4 ? sn0[e & 3] : sn1[e & 3];
                        lo[e] = (a * cs - bb * sn) * sc_; hi[e] = (a * sn + bb * cs) * sc_; }
                    v4u olo, ohi; olo.x = cvtpk(lo[0], lo[1]); olo.y = cvtpk(lo[2], lo[3]); olo.z = cvtpk(lo[4], lo[5]); olo.w = cvtpk(lo[6], lo[7]);
                    ohi.x = cvtpk(hi[0], hi[1]); ohi.y = cvtpk(hi[2], hi[3]); ohi.z = cvtpk(hi[4], hi[5]); ohi.w = cvtpk(hi[6], hi[7]);
                    LAS unsigned char* T = which == 0 ? Qt : Kt;
                    *(LAS v4u*)(T + toff(t, c0)) = olo; *(LAS v4u*)(T + toff(t, c0 + 32)) = ohi; }
                __builtin_amdgcn_sched_barrier(0);
            }
#pragma unroll
            for (int j = 0; j < 4; ++j) { const int id = li + 128 * j, t = id >> 3, pc = id & 7;
                *(LAS v4u*)(Vt + toff(t, 8 * pc)) = *(const v4u*)(PJ + (rowc + t) * NPROJ + 512 + hd * 64 + 8 * pc); }
            if (li < 64) { ECM[hd * 64 + li] = ex2(32.f * lg2); ETL[hd * 64 + li] = ex2(32.f * lg2); }
            dsum += 64.f * lg2;
        } else if (BR == 1) {
            const int k = lane, half = th;
            const float lb = ((const float*)(ws + WS_LB))[l * 256 + hd * 64 + k];
            const bf16* src = PJ + (rowc + 32 * half) * NPROJ + hd * 64 + k;
            float run[32]; float acc = 0.f;
#pragma unroll
            for (int t = 0; t < 32; ++t) { const float fr = bf2f(src[(size_t)t * NPROJ + 1280]); const float f = lb + (1.f - lb) * sigm(fr); acc += __builtin_amdgcn_logf(f); run[t] = acc; if ((t & 7) == 7) __builtin_amdgcn_sched_barrier(0); }
            const float tot = acc;
#pragma unroll
            for (int t = 0; t < 32; ++t) {
                const float fr = bf2f(src[(size_t)t * NPROJ + 1280]);
                const float eq = half == 0 ? run[t] - tot : run[t], ek = half == 0 ? tot - run[t] : -run[t];
                if (OUT) { const float gq = bf2f(src[(size_t)t * NPROJ + 1024]); *(LAS bf16*)(Qt + toff(32 * half + t, k)) = (bf16)f2bf(silu(gq) * ex2(eq)); }
                *(LAS bf16*)(Kt + toff(32 * half + t, k)) = (bf16)f2bf((1.f - lb) * sigm(-fr) * ex2(ek));
                *(LAS bf16*)(Vt + toff(32 * half + t, k)) = src[(size_t)t * NPROJ + 1536];
                if ((t & 3) == 3) __builtin_amdgcn_sched_barrier(0);
            }
            if (half == 0) ECM[hd * 64 + k] = ex2(tot); else ETL[hd * 64 + k] = ex2(tot);
            dsum += tot;
        } else {
            if (tid < 256) { const int t = tid >> 2, h = tid & 3; const float dtv = softplus(((const float*)(ws + WS_DT))[(rowc + t) * 4 + h] + INP(F, 25)[l * 4 + h]);
                DTS[h * 64 + t] = dtv; LA[h * 64 + t] = dtv * (-expf(INP(F, 26)[l * 4 + h])) * 1.4426950408889634f; }
            __syncthreads();
            if (wv == 0) {
#pragma unroll
                for (int h = 0; h < 4; ++h) { float v = LA[h * 64 + lane];
#pragma unroll
                    for (int o = 1; o < 64; o <<= 1) { const float u = __shfl_up(v, o); if (lane >= o) v += u; }
                    const float tot = __shfl(v, 63); CUM[h * 64 + lane] = v; DTW[h * 64 + lane] = DTS[h * 64 + lane] * ex2(tot - v); if (lane == 0) TOT[h] = tot; }
            }
            __syncthreads();
            { const int cc = tid; const float* cw = INP(F, 23) + l * 2048; const float w0 = cw[cc], w1 = cw[512 + cc], w2 = cw[1024 + cc], w3 = cw[1536 + cc], cb = INP(F, 24)[l * 512 + cc];
              const bf16* src = PJ + rowc * NPROJ + 2816 + cc; const int T0 = sc * 256 + c * 64;
              float x0 = T0 >= 3 ? bf2f(*(src - 3 * (ptrdiff_t)NPROJ)) : 0.f, x1 = T0 >= 2 ? bf2f(*(src - 2 * (ptrdiff_t)NPROJ)) : 0.f, x2 = T0 >= 1 ? bf2f(*(src - (ptrdiff_t)NPROJ)) : 0.f;
              const int role = cc >> 8 == 0 ? 0 : (cc < 384 ? 1 : 2), hx = cc >> 6, n = cc & 63, g = (cc >> 6) & 1;
              LAS unsigned char* T1 = role == 0 ? L + (4 + 2 * hx) * TILE_B : role == 1 ? L + (2 * g + 1) * TILE_B : L + (2 * g) * TILE_B;
              LAS unsigned char* T2 = L + (5 + 2 * (hx & 3)) * TILE_B;
              if (!(role == 2 && !OUT)) {
#pragma unroll 4
              for (int t = 0; t < 64; ++t) { const float x3 = bf2f(src[(size_t)t * NPROJ]); const float y = silu(cb + w0 * x0 + w1 * x1 + w2 * x2 + w3 * x3); x0 = x1; x1 = x2; x2 = x3;
                  *(LAS bf16*)(T1 + toff(t, n)) = (bf16)f2bf(y);
                  if (role == 0) *(LAS bf16*)(T2 + toff(t, n)) = (bf16)f2bf(y * DTW[hx * 64 + t]); } }
            }
        }
        __syncthreads();
        if (BR == 2) dsum += TOT[hd];
        f32x16 OT[2], OI[2];
#pragma unroll
        for (int i = 0; i < 16; ++i) { OT[0][i] = 0.f; OT[1][i] = 0.f; OI[0][i] = 0.f; OI[1][i] = 0.f; }
        if (OUT) {
#pragma unroll
            for (int si = 0; si < 2; ++si) {
                if (si > th) continue;
                f32x16 ST;
#pragma unroll
                for (int i = 0; i < 16; ++i) ST[i] = 0.f;
#pragma unroll
                for (int ks = 0; ks < 4; ++ks) ST = MFMA32(ld128(Kt + toff(32 * si + r, 16 * ks + 8 * hh)), ld128(Qt + toff(32 * th + r, 16 * ks + 8 * hh)), ST);
                if (BR == 2) { const float ct = CUM[hd * 64 + 32 * th + r];
#pragma unroll
                    for (int g4 = 0; g4 < 4; ++g4) { const f32x4 cs = *(LAS f32x4*)(CUM + hd * 64 + 32 * si + 8 * g4 + 4 * hh), ds = *(LAS f32x4*)(DTS + hd * 64 + 32 * si + 8 * g4 + 4 * hh);
#pragma unroll
                        for (int e = 0; e < 4; ++e) { const int i = 4 * g4 + e; const bool keep = (si < th) || (crow(i, hh) <= r); ST[i] = keep ? ST[i] * ex2(ct - cs[e]) * ds[e] : 0.f; } }
                } else if (si == th) {
#pragma unroll
                    for (int i = 0; i < 16; ++i) ST[i] = (crow(i, hh) <= r) ? ST[i] : 0.f;
                }
                __builtin_amdgcn_sched_barrier(0);
                const bf16x8 p0 = packacc<0>(ST), p1 = packacc<1>(ST);
#pragma unroll
                for (int vi = 0; vi < 2; ++vi) { OT[vi] = MFMA32(trfrag<true>(Vt, 32 * si, 32 * vi, lane), p0, OT[vi]); OT[vi] = MFMA32(trfrag<true>(Vt, 32 * si + 16, 32 * vi, lane), p1, OT[vi]); }
            }
        }
        __builtin_amdgcn_sched_barrier(0);
        if (BR != 2) {
#pragma unroll
            for (int ki = 0; ki < 2; ++ki)
#pragma unroll
                for (int g4 = 0; g4 < 4; ++g4) { const f32x4 e4 = *(LAS f32x4*)(ECM + hd * 64 + 32 * ki + 8 * g4 + 4 * hh);
#pragma unroll
                    for (int e = 0; e < 4; ++e) { H[ki][0][4 * g4 + e] *= e4[e]; H[ki][1][4 * g4 + e] *= e4[e]; } }
        }
        __builtin_amdgcn_sched_barrier(0);
        if (OUT) {
#pragma unroll
            for (int ki = 0; ki < 2; ++ki) {
                const bf16x8 q0 = cat8(ld64(Qt + toff(32 * th + r, 32 * ki + 4 * hh)), ld64(Qt + toff(32 * th + r, 32 * ki + 8 + 4 * hh)));
                const bf16x8 q1 = cat8(ld64(Qt + toff(32 * th + r, 32 * ki + 16 + 4 * hh)), ld64(Qt + toff(32 * th + r, 32 * ki + 24 + 4 * hh)));
#pragma unroll
                for (int vj = 0; vj < 2; ++vj) {
                    if (BR == 2) { OI[vj] = MFMA32(packacc<0>(H[ki][vj]), q0, OI[vj]); OI[vj] = MFMA32(packacc<1>(H[ki][vj]), q1, OI[vj]); }
                    else { OT[vj] = MFMA32(packacc<0>(H[ki][vj]), q0, OT[vj]); OT[vj] = MFMA32(packacc<1>(H[ki][vj]), q1, OT[vj]); } }
            }
            if (BR == 2) { const float ect = ex2(CUM[hd * 64 + 32 * th + r]);
#pragma unroll
                for (int i = 0; i < 16; ++i) { OT[0][i] += OI[0][i] * ect; OT[1][i] += OI[1][i] * ect; } }
        }
        __builtin_amdgcn_sched_barrier(0);
        if (BR == 2) { const float et = ex2(TOT[hd]);
#pragma unroll
            for (int i = 0; i < 16; ++i) { H[0][0][i] *= et; H[0][1][i] *= et; H[1][0][i] *= et; H[1][1][i] *= et; } }
#pragma unroll
        for (int s4 = 0; s4 < 4; ++s4) {
            const bf16x8 a0 = trfrag<false>(Kt, 16 * s4, 0, lane), a1 = trfrag<false>(Kt, 16 * s4, 32, lane);
            LAS unsigned char* VV = BR == 2 ? Wt : Vt;
            const bf16x8 b0 = trfrag<false>(VV, 16 * s4, 0, lane), b1 = trfrag<false>(VV, 16 * s4, 32, lane);
            H[0][0] = MFMA32(a0, b0, H[0][0]); H[0][1] = MFMA32(a0, b1, H[0][1]); H[1][0] = MFMA32(a1, b0, H[1][0]); H[1][1] = MFMA32(a1, b1, H[1][1]);
            __builtin_amdgcn_sched_barrier(0);
        }
        if (BR != 2) {
#pragma unroll
            for (int ki = 0; ki < 2; ++ki)
#pragma unroll
                for (int g4 = 0; g4 < 4; ++g4) { const f32x4 e4 = *(LAS f32x4*)(ETL + hd * 64 + 32 * ki + 8 * g4 + 4 * hh);
#pragma unroll
                    for (int e = 0; e < 4; ++e) { H[ki][0][4 * g4 + e] *= e4[e]; H[ki][1][4 * g4 + e] *= e4[e]; } }
        }
        __builtin_amdgcn_sched_barrier(0);
#ifdef X_NOEPI
        if (OUT) { asm volatile("" :: "v"(OT[0]), "v"(OT[1])); }
        if (false) {
#else
        if (OUT) {
#endif
            const size_t rowt = rowc + 32 * th + r;
            float ss = 0.f;
            if (BR == 2) { const float Dh = INP(F, 27)[l * 4 + hd];
#pragma unroll
                for (int vi = 0; vi < 2; ++vi)
#pragma unroll
                    for (int g4 = 0; g4 < 4; ++g4) { const int v0 = 32 * vi + 8 * g4 + 4 * hh;
                        const v2u xz = *(LAS v2u*)(Vt + toff(32 * th + r, v0)); const v2u zz = *(const v2u*)(PJ + rowt * NPROJ + 2560 + hd * 64 + v0);
#pragma unroll
                        for (int e = 0; e < 4; ++e) { const unsigned xw = xz[e >> 1], zw = zz[e >> 1]; const float x = (e & 1) ? __uint_as_float(xw & 0xffff0000u) : __uint_as_float(xw << 16), z = (e & 1) ? __uint_as_float(zw & 0xffff0000u) : __uint_as_float(zw << 16);
                            const float my = (OT[vi][4 * g4 + e] + Dh * x) * silu(z); OT[vi][4 * g4 + e] = my; ss += my * my; } }
                ss += __shfl_xor(ss, 32);
                if (hh == 0) SSQ[hd * 64 + 32 * th + r] = ss;
                __syncthreads();
                ss = (SSQ[32 * th + r] + SSQ[64 + 32 * th + r]) + (SSQ[128 + 32 * th + r] + SSQ[192 + 32 * th + r]);
            } else {
#pragma unroll
                for (int i = 0; i < 16; ++i) ss += OT[0][i] * OT[0][i] + OT[1][i] * OT[1][i];
                ss += __shfl_xor(ss, 32);
            }
            const float rs = 1.f / sqrtf(ss * (BR == 2 ? 1.f / 256.f : 1.f / 64.f) + EPS);
            const float* nw = INP(F, BR == 0 ? 10 : BR == 1 ? 12 : 28) + l * 256 + hd * 64;
            LAS unsigned char* STG = BR == 2 ? Vt : Qt;
#pragma unroll
            for (int vi = 0; vi < 2; ++vi)
#pragma unroll
                for (int g4 = 0; g4 < 4; ++g4) { const int v0 = 32 * vi + 8 * g4 + 4 * hh; const f32x4 w4 = *(const f32x4*)(nw + v0);
                    float o[4];
                    if (BR == 2) {
#pragma unroll
                        for (int e = 0; e < 4; ++e) o[e] = OT[vi][4 * g4 + e] * rs * w4[e];
                    } else { const v2u gz = *(const v2u*)(PJ + rowt * NPROJ + (BR == 0 ? 768 : 1792) + hd * 64 + v0);
#pragma unroll
                        for (int e = 0; e < 4; ++e) { const unsigned gw = gz[e >> 1]; const float g = (e & 1) ? __uint_as_float(gw & 0xffff0000u) : __uint_as_float(gw << 16); o[e] = OT[vi][4 * g4 + e] * rs * w4[e] * silu(g); } }
                    v2u pk; pk.x = cvtpk(o[0], o[1]); pk.y = cvtpk(o[2], o[3]);
                    *(LAS v2u*)(STG + toff(32 * th + r, v0)) = pk; __builtin_amdgcn_sched_barrier(0); }
#pragma unroll
            for (int it = 0; it < 4; ++it) { const int rw = it * 8 + (lane >> 3), pc = lane & 7;
                const v4u v = *(LAS v4u*)(STG + toff(32 * th + rw, 8 * pc));
                *(v4u*)(MX + (rowc + 32 * th + rw) * DM + (BR == 0 ? 0 : BR == 1 ? 256 : 768) + hd * 64 + 8 * pc) = v; }
        }
        __syncthreads();
    }
    if (!OUT) {
        const size_t u = (size_t)(pm * 12 + hid);
        if (th == 0) {
#pragma unroll
            for (int ki = 0; ki < 2; ++ki)
#pragma unroll
                for (int vj = 0; vj < 2; ++vj)
#pragma unroll
                    for (int i = 0; i < 16; ++i) SLOC[(u * 64 + 32 * ki + crow(i, hh)) * 64 + 32 * vj + r] = H[ki][vj][i];
        }
        if (BR == 1) { LAS float* XC = ECM;
            if (th == 1) XC[hd * 64 + lane] = dsum;
            __syncthreads();
            if (th == 0) DTOT[u * 64 + lane] = dsum + XC[hd * 64 + lane];
        } else if (th == 0) DTOT[u * 64 + lane] = dsum;
    } else if (sc == 7) {
        float* ho = OUTP(F) + (BR == 0 ? O_PRET : BR == 1 ? O_PHGRN : O_PM2) + (size_t)((l * NB + b) * 4 + hd) * 4096;
        if (th == 0) {
#pragma unroll
            for (int ki = 0; ki < 2; ++ki)
#pragma unroll
                for (int vj = 0; vj < 2; ++vj)
#pragma unroll
                    for (int i = 0; i < 16; ++i) ho[(32 * ki + crow(i, hh)) * 64 + 32 * vj + r] = H[ki][vj][i];
        }
        if (BR == 2) { float* cbo = OUTP(F) + O_PCONV + (size_t)(l * NB + b) * 1536;
            for (int e = tid; e < 1536; e += NTHR) { const int i = e / 512, cc = e % 512; cbo[e] = bf2f(PJ[(row0 + 253 + i) * NPROJ + 2816 + cc]); } }
    }
}
DI void mixers_m1(Frame& F, int l) {
    for (int u = F.bx; u < 192; u += F.G) { const int pm = u / 3, br = u % 3;
#ifndef X_NOM1
#ifndef X_NOA0
        if (br == 0) lin_unit<0, false>(F, l, pm);
#endif
#ifndef X_NOA1
        if (br == 1) lin_unit<1, false>(F, l, pm);
#endif
#ifndef X_NOA2
        if (br == 2) lin_unit<2, false>(F, l, pm);
#endif
#endif
        }
}
DI void mixers_m3(Frame& F, int l) {
    float* out = OUTP(F);
    constexpr int U_LR = 192, U_S5 = 128, U_SLR = 1536, U_SS5 = 2048, U_ALL = U_LR + U_S5 + U_SLR + U_SS5;
    for (int u = F.bx; u < U_ALL; u += F.G) {
        int r = u;
        if (r < U_LR) { const int pm = r / 3, br = r % 3;
#ifndef X_NOB0
            if (br == 0) lin_unit<0, true>(F, l, pm);
#endif
#ifndef X_NOB1
            if (br == 1) lin_unit<1, true>(F, l, pm);
#endif
#ifndef X_NOB2
            if (br == 2) lin_unit<2, true>(F, l, pm);
#endif
            continue; } r -= U_LR;
        if (r < U_S5) { const int b = r >> 4, g = r & 15;
            s5_unit(F, l, g, b * SEQL, SEQL, nullptr, nullptr, out + O_PS5R + (size_t)((l * NB + b) * 16 + g) * 64, out + O_PS5I + (size_t)((l * NB + b) * 16 + g) * 64); continue; } r -= U_S5;
        if (r < U_SLR) { const int s = r / 12, hid = r % 12, br = hid >> 2, h = hid & 3;
            const size_t so = (size_t)((l * MSAMP + s) * 4 + h) * 4096;
            const float* hi = INP(F, br == 0 ? 2 : br == 1 ? 3 : 6) + so; float* ho = out + (br == 0 ? O_SRET : br == 1 ? O_SHGRN : O_SM2) + so;
            linrec_unit(F, l, br, h, MPROMPT + s, 1, 2048, hi, ho, INP(F, 7) + (size_t)(l * MSAMP + s) * 1536, out + O_SCONV + (size_t)(l * MSAMP + s) * 1536); continue; } r -= U_SLR;
        { const int s = r >> 4, g = r & 15; const size_t so = (size_t)((l * MSAMP + s) * 16 + g) * 64;
            s5_unit(F, l, g, MPROMPT + s, 1, INP(F, 4) + so, INP(F, 5) + so, out + O_SS5R + so, out + O_SS5I + so); }
    }
}
DI void fixups(Frame& F, int l) {
    unsigned char* ws = WSP(F);
    bf16* MX = (bf16*)(ws + WS_MIXED); const float* MSQ = (const float*)(ws + WS_MSQ); const float* nw = INP(F, 28) + l * 256;
    const bf16* GY = (const bf16*)(ws + WS_GY); const bf16* ZB = (const bf16*)(ws + WS_ZB); const bf16* PJ = (const bf16*)(ws + WS_PROJ);
    const int gw = F.vcu * NWAVES + F.wave, NGW = F.G * NWAVES, lane = F.lane;
    const f32x4 w4 = *((const f32x4*)nw + lane);
    for (int m = gw; m < MVALID; m += NGW) {
        const f32x4 q = *(const f32x4*)(MSQ + (size_t)m * 4); const float sc = 1.f / sqrtf(((q.x + q.y) + (q.z + q.w)) * (1.f / 256.f) + EPS);
        if (m >= MPROMPT) {
        v2u* p = (v2u*)(MX + (size_t)m * DM + 768) + lane; const v2u x = *p;
        v2u o; o.x = pk2(__uint_as_float(x.x << 16) * sc * w4.x, __uint_as_float(x.x & 0xffff0000u) * sc * w4.y); o.y = pk2(__uint_as_float(x.y << 16) * sc * w4.z, __uint_as_float(x.y & 0xffff0000u) * sc * w4.w);
        *p = o; }
        const v2u g = *((const v2u*)(GY + (size_t)m * 256) + lane), z = *((const v2u*)(ZB + (size_t)m * 256) + lane), sg = *((const v2u*)(PJ + (size_t)m * NPROJ + 2304) + lane);
        float r[4];
#pragma unroll
        for (int i = 0; i < 2; ++i) {
            r[2 * i] = __uint_as_float(g[i] << 16) * sigm(__uint_as_float(z[i] << 16)) * silu(__uint_as_float(sg[i] << 16));
            r[2 * i + 1] = __uint_as_float(g[i] & 0xffff0000u) * sigm(__uint_as_float(z[i] & 0xffff0000u)) * silu(__uint_as_float(sg[i] & 0xffff0000u)); }
        v2u o2; o2.x = pk2(r[0], r[1]); o2.y = pk2(r[2], r[3]);
        *((v2u*)(MX + (size_t)m * DM + 512) + lane) = o2;
    }
}
__global__ void __launch_bounds__(NTHR, 2) mk_fwd(Args args) {
    extern __shared__ __attribute__((aligned(16))) unsigned char lds[];
    Frame F;
    F.lds = (LAS unsigned char*)lds; F.MISC = (volatile LAS unsigned*)(F.lds + MISC_OFF);
    const int wave0 = __builtin_amdgcn_readfirstlane(threadIdx.x >> 6);
    F.tid = threadIdx.x; F.lane = F.tid & 63; F.wave = wave0;
    F.G = gridDim.x; { const int bx = blockIdx.x; F.vcu = (F.G % 8 == 0) ? (bx % 8) * (F.G / 8) + bx / 8 : bx; }
    F.ka = (const float* const*)__builtin_amdgcn_kernarg_segment_ptr(); F.out_ = args.out; F.ws_ = args.ws; F.ctl = (gu32*)(args.ws + WS_CTL);
    for (int u = F.tid; u < (LDS_BYTES - LDSCTL_OFF) / 4; u += NTHR) ((LAS unsigned*)(F.lds + LDSCTL_OFF))[u] = 0u;
    __syncthreads();
    XcdBarrier bar; bar.bar = (unsigned*)(F.ctl + CW_BAR); bar.x = 0; bar.st = nullptr;
    if (MK_N_LAUNCHES == 1) bar = xcd_barrier_post((unsigned*)(F.ctl + CW_BAR), F.MISC + 8);
    const int lo = args.ph_lo, hi = args.ph_hi;
#pragma unroll 1
    for (int ph = lo; ph < hi; ++ph) {
        int tid; asm volatile("v_mbcnt_lo_u32_b32 %0, -1, 0\n\tv_mbcnt_hi_u32_b32 %0, -1, %0" : "=v"(tid)); tid += wave0 * 64;
        F.tid = tid; F.lane = tid & 63; F.wave = __builtin_amdgcn_readfirstlane(tid >> 6);
        { int bx = blockIdx.x, G = gridDim.x; asm volatile("" : "+s"(bx), "+s"(G)); F.bx = bx; F.G = G; F.vcu = (G % 8 == 0) ? (bx % 8) * (G / 8) + bx / 8 : bx; }
        const int l = ph >= 8 ? 1 : 0, sub = ph == 0 ? -1 : ph - 1 - 7 * l;
        if (ph == 0) { prologue(F); }
        else if (sub == 0) {
            unsigned char* ws = WSP(F); bf16* XB = (bf16*)(ws + WS_XB); bf16* PROJ = (bf16*)(ws + WS_PROJ);
            pg8::Gemm g{XB, (const bf16*)(ws + WS_WINT) + (size_t)l * NPROJ * DM, MPAD, NPROJ, DM}; pg8::StaticOrder S; S.init(MPAD, NPROJ, F.G, F.bx);
            pg8::EpiBf16<0> E{PROJ, NPROJ, nullptr, 0, 0, 1.f};
#ifndef X_NOGEMM
            pg8::gemm_phase<pg8::EpiBf16<0>, pg8::StaticOrder, true, true>(F.lds + RING_OFF, g, S, E, tid);
#endif
        } else if (sub == 1) { mixers_m1(F, l); }
        else if (sub == 2) { mixers_m3(F, l); }
        else if (sub == 3) {
            unsigned char* ws = WSP(F); bf16* GY = (bf16*)(ws + WS_GY);
            pg8::Gemm g{GY, (const bf16*)(ws + WS_WGLUT) + (size_t)l * 65536, MPAD, 256, 256}; pg8::StaticOrder S; S.init(MPAD, 256, F.G, F.bx);
            pg8::EpiBf16<0> E{(bf16*)(ws + WS_ZB), 256, INP(F, 22) + l * 256, 0, 0, 1.f};
#ifndef X_NOGEMM
            pg8::gemm_phase<pg8::EpiBf16<0>, pg8::StaticOrder, true, true>(F.lds + RING_OFF, g, S, E, tid);
#endif
        } else if (sub == 4) { fixups(F, l); }
        else if (sub == 5) {
            unsigned char* ws = WSP(F); bf16* MX = (bf16*)(ws + WS_MIXED);
            pg8::Gemm g{MX, (const bf16*)(ws + WS_WOUTT) + (size_t)l * DM * DM, MPAD, DM, DM}; pg8::StaticOrder S; S.init(MPAD, DM, F.G, F.bx);
            pg8::EpiResid E{INP(F, 0), INP(F, 1), OUTP(F), l == 0 ? 1 : 0};
#ifndef X_NOGEMM
            pg8::gemm_phase<pg8::EpiResid, pg8::StaticOrder, true, true>(F.lds + RING_OFF, g, S, E, tid);
#endif
        } else { if (l == 0) aprep(F, 1); else final_norm(F); }
        if (ph + 1 < hi) xcd_barrier(bar);
    }
}

extern "C" void kernel_launch(void* const* d_in, const int* in_sizes, int n_in, void* d_out, int out_size, void* d_ws, size_t ws_size, hipStream_t stream) {
    static int grid = 0;
    if (grid == 0) {
        if (n_in != 31 || out_size != (int)O_TOTAL || ws_size < WS_END) { fprintf(stderr, "kernel_launch: unexpected shapes: n_in %d out %d ws %zu\n", n_in, out_size, ws_size); grid = -1; return; }
        int dev = 0, cus = 0, per_cu = 0;
        if (hipGetDevice(&dev) != hipSuccess || hipDeviceGetAttribute(&cus, hipDeviceAttributeMultiprocessorCount, dev) != hipSuccess) { grid = -1; return; }
        if (hipFuncSetAttribute((const void*)mk_fwd, hipFuncAttributeMaxDynamicSharedMemorySize, LDS_BYTES) != hipSuccess) { fprintf(stderr, "kernel_launch: hipFuncSetAttribute failed\n"); grid = -1; return; }
        if (hipOccupancyMaxActiveBlocksPerMultiprocessor(&per_cu, (const void*)mk_fwd, NTHR, LDS_BYTES) != hipSuccess || per_cu < 1) { fprintf(stderr, "kernel_launch: occupancy query says %d\n", per_cu); per_cu = 1; }
        (void)hipGetLastError();
        grid = cus;
    }
    if (grid < 0) return;
    (void)hipMemsetAsync((char*)d_ws + WS_CTL, 0, CTL_ZERO_BYTES, stream);
    Args a{};
    for (int i = 0; i < 31; ++i) a.in[i] = (const float*)d_in[i];
    a.out = (float*)d_out; a.ws = (unsigned char*)d_ws;
    if (MK_N_LAUNCHES == 1) { a.ph_lo = 0; a.ph_hi = N_PHASES; a.li = 0; hipLaunchKernelGGL(mk_fwd, dim3(grid), dim3(NTHR), LDS_BYTES, stream, a); }
    else for (int p = 0; p < N_PHASES; ++p) { a.ph_lo = p; a.ph_hi = p + 1; a.li = p; hipLaunchKernelGGL(mk_fwd, dim3(grid), dim3(NTHR), LDS_BYTES, stream, a); }
}
```

```cpp
#include <hip/hip_runtime.h>
#include <cstdio>
#include <cstdint>
namespace pg8 {
#define PG8_LAS __attribute__((address_space(3)))
typedef unsigned short bf16_t;
typedef short bf16x8 __attribute__((ext_vector_type(8)));
typedef float f32x4 __attribute__((ext_vector_type(4)));
typedef unsigned u32x4 __attribute__((ext_vector_type(4)));
constexpr int BM = 256, BK = 64, HALF = 128, HTB = HALF * BK * 2  , STAGE_BYTES = 8 * HTB, NXCD = 8, WGM = 8;

__host__ __device__ __forceinline__ int lds_byte(int r, int c) { const int st = (r >> 4) * 2 + (c >> 5), rr = r & 15, cc = c & 31, ob = rr * 64 + cc * 2; return st * 1024 + (ob ^ (((ob >> 9) & 1) << 5)); }
__host__ __device__ __forceinline__ void stage_rc(int b, int& R, int& C) { const int st = b / 1024, sb = b % 1024, swz = sb ^ (((sb >> 9) & 1) << 5); R = (st >> 1) * 16 + swz / 64; C = (st & 1) * 32 + (swz % 64) / 2; }
__host__ __device__ __forceinline__ int perm32(int rho) { const int n = rho >> 4, i = rho & 15; return 8 * (i >> 2) + 4 * n + (i & 3); }

struct Unit { int pm, pn; };
struct Gemm { const bf16_t* A; const bf16_t* Bt; int M, N, K; };

struct StaticOrder {
    int nM, nN, nwg, G, c;
    __host__ __device__ void init(int M, int N, int G_, int c_) { nM = M / BM; nN = N / BM; nwg = nM * nN; G = G_; c = c_; }
    __host__ __device__ bool next(int i, Unit& u) const {
        const long L = (long)i * G + c; if (L >= nwg) return false;
        int wgid = (int)L; { const int q = nwg / NXCD, r = nwg % NXCD, xcd = wgid % NXCD, off = wgid / NXCD; wgid = (xcd < r ? xcd * (q + 1) : r * (q + 1) + (xcd - r) * q) + off; }
        const int nig = WGM * nN, gid = wgid / nig, fm = gid * WGM, gsz = (nM - fm) < WGM ? (nM - fm) : WGM;
        u.pm = fm + ((wgid % nig) % gsz); u.pn = (wgid % nig) / gsz; return true;
    }
    __device__ __forceinline__ void a_ready(const Unit&) const {}
    __device__ __forceinline__ void done(const Unit&) const {}
};

__device__ __forceinline__ unsigned cvt_pk_bf16(float lo, float hi) { unsigned r; asm volatile("v_cvt_pk_bf16_f32 %0, %1, %2" : "=v"(r) : "v"(lo), "v"(hi)); return r; }
typedef float f32x2 __attribute__((ext_vector_type(2)));
__device__ __forceinline__ f32x2 gelu_pk(f32x2 v) {
    const f32x2 av = __builtin_elementwise_abs(v), d = av * 0.2316418882f + 1.0f;
    f32x2 t; t.x = __builtin_amdgcn_rcpf(d.x); t.y = __builtin_amdgcn_rcpf(d.y);
    f32x2 q = t * 0.5307027145f + (-0.7265760135f); q = q * t + 0.7107068705f; q = q * t + (-0.142248368f); q = q * t + 0.127414796f; q = q * t;
    const f32x2 s = (v * v) * (-0.72134752044f);
    f32x2 e; e.x = __builtin_amdgcn_exp2f(s.x); e.y = __builtin_amdgcn_exp2f(s.y);
    const f32x2 m = v * (q * e), r = v - m;
    f32x2 o; o.x = v.x < 0.f ? m.x : r.x; o.y = v.y < 0.f ? m.y : r.y; return o;
}

template <int ACT  > struct EpiBf16 {
    static constexpr bool PERM = true, AFTER_DRAIN = false; static_assert(ACT == 0 || ACT == 1, "EpiBf16: ACT is 0 (none) or 1 (gelu_pk)");
    bf16_t* O; int ldc; const float* bias; int split_cols; size_t split_stride; float scale0;
    __device__ __forceinline__ void operator()(const f32x4 (&acc)[2][2][4][2], const Unit& u, int wr, int wc, int fr, int fq) const {
        const int row0 = u.pm * BM + wr * 64 + fr; int colt = u.pn * BM; bf16_t* base = O;
        float sc = 1.f; if (split_cols) { const int t = colt / split_cols; base += (size_t)t * split_stride; colt -= t * split_cols; if (t == 0) sc = scale0; }
        const int col0 = colt + wc * 32 + 8 * fq, bcol0 = u.pn * BM + wc * 32 + 8 * fq;
        f32x4 bv[2][2];
#pragma unroll
        for (int bj = 0; bj < 2; ++bj)
#pragma unroll
            for (int n = 0; n < 2; ++n) bv[bj][n] = bias ? *(const f32x4*)(bias + bcol0 + bj * HALF + 4 * n) : (f32x4){0.f, 0.f, 0.f, 0.f};
#pragma unroll
        for (int ai = 0; ai < 2; ++ai)
#pragma unroll
            for (int m = 0; m < 4; ++m) { bf16_t* rowp = base + (size_t)(row0 + ai * HALF + m * 16) * ldc + col0;
#pragma unroll
                for (int bj = 0; bj < 2; ++bj) { f32x4 v0 = acc[ai][bj][m][0] + bv[bj][0], v1 = acc[ai][bj][m][1] + bv[bj][1];
                    if (ACT == 1) { f32x2 a = gelu_pk((f32x2){v0[0], v0[1]}), b = gelu_pk((f32x2){v0[2], v0[3]}), c = gelu_pk((f32x2){v1[0], v1[1]}), d = gelu_pk((f32x2){v1[2], v1[3]});
                        v0 = (f32x4){a.x, a.y, b.x, b.y}; v1 = (f32x4){c.x, c.y, d.x, d.y}; }
                    v0 = v0 * sc; v1 = v1 * sc; u32x4 w; w.x = cvt_pk_bf16(v0[0], v0[1]); w.y = cvt_pk_bf16(v0[2], v0[3]); w.z = cvt_pk_bf16(v1[0], v1[1]); w.w = cvt_pk_bf16(v1[2], v1[3]);
                    *(u32x4*)(rowp + bj * HALF) = w; } }
    }
};

__device__ __forceinline__ float bf2f(unsigned short b) { return __uint_as_float((unsigned)b << 16); }
__device__ __forceinline__ float ex2(float x) { return __builtin_amdgcn_exp2f(x); }
__device__ __forceinline__ float fexp(float x) { return __builtin_amdgcn_exp2f(x * 1.4426950408889634f); }
__device__ __forceinline__ float sigm(float x) { return 1.f / (1.f + fexp(-x)); }
__device__ __forceinline__ float silu(float x) { return x / (1.f + fexp(-x)); }
struct EpiResid {
    static constexpr bool PERM = false, AFTER_DRAIN = false;
    const float* xp; const float* xs; float* out; int layer0;
    __device__ __forceinline__ void operator()(const f32x4 (&acc)[2][2][4][2], const Unit& u, int wr, int wc, int fr, int fq) const {
        const int row0 = u.pm * BM + wr * 64 + fr, col0 = u.pn * BM + wc * 32 + 4 * fq;
#pragma unroll
        for (int ai = 0; ai < 2; ++ai)
#pragma unroll
            for (int m = 0; m < 4; ++m) { const int row = row0 + ai * HALF + m * 16;
                if (row < 16512) {
                    const float* src = layer0 ? (row < 16384 ? xp + (size_t)row * 1024 : xs + (size_t)(row - 16384) * 1024) : out + (size_t)row * 1024;
                    float* dst = out + (size_t)row * 1024;
#pragma unroll
                    for (int bj = 0; bj < 2; ++bj)
#pragma unroll
                        for (int n = 0; n < 2; ++n) { const int c = col0 + bj * HALF + n * 16; *(f32x4*)(dst + c) = *(const f32x4*)(src + c) + acc[ai][bj][m][n]; }
                }
                asm volatile("" ::: "memory"); }
    }
};
struct EpiGlu {
    static constexpr bool PERM = true, AFTER_DRAIN = false;
    const bf16_t* GY; const bf16_t* PROJ; bf16_t* MIXED; const float* bias;
    __device__ __forceinline__ void operator()(const f32x4 (&acc)[2][2][4][2], const Unit& u, int wr, int wc, int fr, int fq) const {
        const unsigned row0 = u.pm * BM + wr * 64 + fr, col0 = wc * 32 + 8 * fq;
        const char* gyb = (const char*)GY; const char* pjb = (const char*)PROJ; char* mxb = (char*)MIXED;
#pragma unroll
        for (int bj = 0; bj < 2; ++bj) { const unsigned c = col0 + bj * HALF;
            const f32x4 b0 = *(const f32x4*)(bias + c), b1 = *(const f32x4*)(bias + c + 4);
#pragma unroll
            for (int ai = 0; ai < 2; ++ai)
#pragma unroll
                for (int m = 0; m < 4; ++m) { const unsigned row = row0 + ai * HALF + m * 16;
                    const f32x4 z0 = acc[ai][bj][m][0] + b0, z1 = acc[ai][bj][m][1] + b1;
                    const u32x4 g = *(const u32x4*)(gyb + (row * 256u + c) * 2u), s = *(const u32x4*)(pjb + (row * 3328u + 2304u + c) * 2u);
                    float o[8];
#pragma unroll
                    for (int i = 0; i < 4; ++i) {
                        const float gl = __uint_as_float(g[i] << 16), gh = __uint_as_float(g[i] & 0xffff0000u), sl = __uint_as_float(s[i] << 16), sh = __uint_as_float(s[i] & 0xffff0000u);
                        const float zl = (2 * i < 4) ? z0[(2 * i) & 3] : z1[(2 * i) & 3], zh = (2 * i + 1 < 4) ? z0[(2 * i + 1) & 3] : z1[(2 * i + 1) & 3];
                        o[2 * i] = gl * sigm(zl) * silu(sl); o[2 * i + 1] = gh * sigm(zh) * silu(sh); }
                    u32x4 w; w.x = cvt_pk_bf16(o[0], o[1]); w.y = cvt_pk_bf16(o[2], o[3]); w.z = cvt_pk_bf16(o[4], o[5]); w.w = cvt_pk_bf16(o[6], o[7]);
                    *(u32x4*)(mxb + (row * 1024u + 512u + c) * 2u) = w;
                    asm volatile("" ::: "memory"); } }
    }
};
template <class Epi, class Sched, bool ALIGN_EPI = false, bool SP2 = false>
__device__ __forceinline__ void gemm_phase(PG8_LAS unsigned char* lds, const Gemm g, const Sched& S, const Epi& E, const int tid) {
    const int wid = __builtin_amdgcn_readfirstlane(tid >> 6), lane = tid & 63, wr = wid >> 2, wc = wid & 3, fr = lane & 15, fq = lane >> 4;
    const int K = g.K, nt = K / BK;
    unsigned voffA[2], voffB[2];
#pragma unroll
    for (int i = 0; i < 2; ++i) { int R, C; stage_rc(tid * 16 + i * 8192, R, C); const int Rb = Epi::PERM ? ((R & ~31) + perm32(R & 31)) : R;
        voffA[i] = (unsigned)(R * K + C) * 2u; voffB[i] = (unsigned)(Rb * K + C) * 2u; }
    const size_t kstep = (size_t)(BK * 2);
    const size_t hstep = (size_t)HALF * K * 2;
    const size_t tstep = 2 * hstep;
    const unsigned ldsw = (unsigned)wid * 1024u;
    const int aoff = lds_byte(wr * 64 + fr, fq * 8), boff = lds_byte(wc * 32 + fr, fq * 8);
#define PG8_SA(b, h) (((b) * 2 + (h)) * HTB)
#define PG8_SB(b, h) ((4 + (b) * 2 + (h)) * HTB)
#define PG8_STAGE(bufoff, gbase, voff) do { _Pragma("unroll") for (int _i = 0; _i < 2; ++_i) \
        __builtin_amdgcn_global_load_lds((const unsigned*)((const char*)(gbase) + (voff)[_i]), (PG8_LAS unsigned*)(lds + (bufoff) + ldsw + _i * 8192), 16, 0, 0); } while (0)
#define PG8_LDA(dst, b, h) do { _Pragma("unroll") for (int m = 0; m < 4; ++m) _Pragma("unroll") for (int k = 0; k < 2; ++k) dst[m][k] = *(const PG8_LAS bf16x8*)(lds + PG8_SA(b, h) + aoff + m * 2048 + k * 1024); } while (0)
#define PG8_LDB(dst, b, h) do { _Pragma("unroll") for (int n = 0; n < 2; ++n) _Pragma("unroll") for (int k = 0; k < 2; ++k) dst[n][k] = *(const PG8_LAS bf16x8*)(lds + PG8_SB(b, h) + boff + n * 2048 + k * 1024); } while (0)
#define PG8_MMA(ai, bj, At, Bt) do { __builtin_amdgcn_s_setprio(1); _Pragma("unroll") for (int m = 0; m < 4; ++m) _Pragma("unroll") for (int n = 0; n < 2; ++n) _Pragma("unroll") for (int k = 0; k < 2; ++k) \
        acc[ai][bj][m][n] = __builtin_amdgcn_mfma_f32_16x16x32_bf16(Bt[n][k], At[m][k], acc[ai][bj][m][n], 0, 0, 0); __builtin_amdgcn_s_setprio(0); } while (0)
#define PG8_WAIT_V(n) asm volatile("s_waitcnt vmcnt(" #n ")" ::: "memory")
#define PG8_WAIT_L(n) asm volatile("s_waitcnt lgkmcnt(" #n ")" ::: "memory")
#define PG8_BAR __builtin_amdgcn_s_barrier()
#define PG8_SCHED __builtin_amdgcn_sched_barrier(0)
    Unit cur, nxt; int ui = 0;
    if (!S.next(0, cur)) return;
    f32x4 acc[2][2][4][2];
#pragma unroll
    for (int a = 0; a < 2; ++a)
#pragma unroll
        for (int b = 0; b < 2; ++b)
#pragma unroll
            for (int m = 0; m < 4; ++m)
#pragma unroll
                for (int n = 0; n < 2; ++n) acc[a][b][m][n] = (f32x4){0.f, 0.f, 0.f, 0.f};
    bf16x8 At[4][2], B0[2][2], B1[2][2];
    const char* cA = (const char*)g.A + (size_t)cur.pm * tstep; const char* cB = (const char*)g.Bt + (size_t)cur.pn * tstep;
    S.a_ready(cur);
    if constexpr (SP2) {
        PG8_STAGE(PG8_SB(0, 0), cB, voffB); PG8_STAGE(PG8_SB(0, 1), cB + hstep, voffB); PG8_STAGE(PG8_SA(0, 0), cA, voffA); PG8_STAGE(PG8_SA(0, 1), cA + hstep, voffA);
        if (wr == 1) PG8_BAR;
        PG8_WAIT_V(2); PG8_BAR;
        PG8_STAGE(PG8_SB(1, 0), cB + kstep, voffB); PG8_STAGE(PG8_SA(1, 0), cA + kstep, voffA); PG8_STAGE(PG8_SB(1, 1), cB + hstep + kstep, voffB);
        PG8_WAIT_V(6); PG8_BAR;
    } else {
        PG8_STAGE(PG8_SB(0, 0), cB, voffB); PG8_STAGE(PG8_SA(0, 0), cA, voffA); PG8_STAGE(PG8_SB(0, 1), cB + hstep, voffB); PG8_STAGE(PG8_SA(0, 1), cA + hstep, voffA);
        if (wr == 1) PG8_BAR;
        PG8_WAIT_V(4); PG8_BAR;
        PG8_STAGE(PG8_SB(1, 0), cB + kstep, voffB); PG8_STAGE(PG8_SA(1, 0), cA + kstep, voffA); PG8_STAGE(PG8_SB(1, 1), cB + hstep + kstep, voffB);
        PG8_WAIT_V(6); PG8_BAR;
    }
    for (;;) {
        const bool has_next = S.next(ui + 1, nxt);
        const char* nA = has_next ? (const char*)g.A + (size_t)nxt.pm * tstep : cA; const char* nB = has_next ? (const char*)g.Bt + (size_t)nxt.pn * tstep : cB;
        for (int t = 0; t < nt; t += 2) {
            const bool last = (t == nt - 2);
            const char* a1 = cA + (size_t)(t + 1) * kstep;
            const char* a2 = last ? nA : cA + (size_t)(t + 2) * kstep; const char* b2 = last ? nB : cB + (size_t)(t + 2) * kstep;
            const char* a3 = a2 + kstep; const char* b3 = b2 + kstep;
            if (last && has_next) S.a_ready(nxt);
            if constexpr (SP2) {
            PG8_LDB(B0, 0, 0); PG8_LDB(B1, 0, 1); PG8_SCHED; PG8_LDA(At, 0, 0); PG8_STAGE(PG8_SA(1, 1), a1 + hstep, voffA);
            PG8_WAIT_V(8); PG8_WAIT_L(0); PG8_BAR; PG8_MMA(0, 0, At, B0); PG8_MMA(0, 1, At, B1); PG8_BAR; PG8_SCHED;
            PG8_LDA(At, 0, 1); PG8_STAGE(PG8_SB(0, 0), b2, voffB); PG8_STAGE(PG8_SB(0, 1), b2 + hstep, voffB); PG8_STAGE(PG8_SA(0, 0), a2, voffA);
            PG8_WAIT_V(8); PG8_WAIT_L(0); PG8_BAR; PG8_MMA(1, 0, At, B0); PG8_MMA(1, 1, At, B1); PG8_BAR; PG8_SCHED;
            PG8_LDB(B0, 1, 0); PG8_LDB(B1, 1, 1); PG8_SCHED; PG8_LDA(At, 1, 0); PG8_STAGE(PG8_SA(0, 1), a2 + hstep, voffA);
            PG8_WAIT_V(8); PG8_WAIT_L(0); PG8_BAR; PG8_MMA(0, 0, At, B0); PG8_MMA(0, 1, At, B1); PG8_BAR; PG8_SCHED;
            PG8_LDA(At, 1, 1); PG8_STAGE(PG8_SB(1, 0), b3, voffB); PG8_STAGE(PG8_SB(1, 1), b3 + hstep, voffB); PG8_STAGE(PG8_SA(1, 0), a3, voffA);
            PG8_WAIT_V(8); PG8_WAIT_L(0); PG8_BAR; PG8_MMA(1, 0, At, B0); PG8_MMA(1, 1, At, B1); PG8_BAR; PG8_SCHED;
            } else {
            PG8_LDB(B0, 0, 0); PG8_SCHED; PG8_LDA(At, 0, 0); PG8_STAGE(PG8_SA(1, 1), a1 + hstep, voffA);
            PG8_WAIT_L(8); PG8_BAR; PG8_WAIT_L(0); PG8_MMA(0, 0, At, B0); PG8_BAR; PG8_SCHED;
            PG8_LDB(B1, 0, 1); PG8_STAGE(PG8_SB(0, 0), b2, voffB);
            PG8_BAR; PG8_WAIT_L(0); PG8_MMA(0, 1, At, B1); PG8_BAR;
            PG8_LDA(At, 0, 1); PG8_STAGE(PG8_SA(0, 0), a2, voffA);
            PG8_BAR; PG8_WAIT_L(0); PG8_MMA(1, 0, At, B0); PG8_BAR; PG8_SCHED;
            PG8_STAGE(PG8_SB(0, 1), b2 + hstep, voffB);
            PG8_WAIT_V(6); PG8_BAR; PG8_MMA(1, 1, At, B1); PG8_BAR;
            PG8_LDB(B0, 1, 0); PG8_SCHED; PG8_LDA(At, 1, 0); PG8_STAGE(PG8_SA(0, 1), a2 + hstep, voffA);
            PG8_WAIT_L(8); PG8_BAR; PG8_WAIT_L(0); PG8_MMA(0, 0, At, B0); PG8_BAR; PG8_SCHED;
            PG8_LDB(B1, 1, 1); PG8_STAGE(PG8_SB(1, 0), b3, voffB);
            PG8_BAR; PG8_WAIT_L(0); PG8_MMA(0, 1, At, B1); PG8_BAR;
            PG8_LDA(At, 1, 1); PG8_STAGE(PG8_SA(1, 0), a3, voffA);
            PG8_BAR; PG8_WAIT_L(0); PG8_MMA(1, 0, At, B0); PG8_BAR; PG8_SCHED;
            PG8_STAGE(PG8_SB(1, 1), b3 + hstep, voffB);
            PG8_WAIT_V(6); PG8_BAR; PG8_MMA(1, 1, At, B1); PG8_BAR;
            }
        }
        if constexpr (ALIGN_EPI) { if (wr == 0) PG8_BAR; }
        if constexpr (!Epi::AFTER_DRAIN) { E(acc, cur, wr, wc, fr, fq); S.done(cur); }
        if (!has_next) break;
#pragma unroll
        for (int a = 0; a < 2; ++a)
#pragma unroll
            for (int b = 0; b < 2; ++b)
#pragma unroll
                for (int m = 0; m < 4; ++m)
#pragma unroll
                    for (int n = 0; n < 2; ++n) acc[a][b][m][n] = (f32x4){0.f, 0.f, 0.f, 0.f};
        cur = nxt; cA = nA; cB = nB; ++ui;
        if constexpr (ALIGN_EPI) { if (wr == 1) PG8_BAR; }
    }
    PG8_WAIT_V(0);
    if constexpr (!ALIGN_EPI) { if (wr == 0) PG8_BAR; }
    PG8_BAR;
    if constexpr (Epi::AFTER_DRAIN) { E.fused(acc, cur, wr, wc, fr, fq, lds, wid, lane); S.done(cur); }
#undef PG8_SA
#undef PG8_SB
#undef PG8_STAGE
#undef PG8_LDA
#undef PG8_LDB
#undef PG8_MMA
#undef PG8_WAIT_V
#undef PG8_WAIT_L
#undef PG8_BAR
#undef PG8_SCHED
}
}

constexpr int NWAVES = 8, NTHR = 512;
#ifndef MK_N_LAUNCHES
#define MK_N_LAUNCHES 1
#endif
constexpr int N_PHASES = 15;
constexpr int DM = 1024, MPROMPT = 16384, MSAMP = 128, MVALID = 16512, MPAD = 16640, SEQL = 2048, NB = 8;
constexpr int NPROJ = 3328, NPROJ_FULL = 3332;
constexpr float EPS = 1e-6f;
constexpr size_t O_Y = 0, O_PRET = 16908288, O_PHGRN = 17170432, O_PS5R = 17432576, O_PS5I = 17448960, O_PM2 = 17465344, O_PCONV = 17727488,
                 O_SRET = 17752064, O_SHGRN = 21946368, O_SS5R = 26140672, O_SS5I = 26402816, O_SM2 = 26664960, O_SCONV = 30859264, O_TOTAL = 31252480;
constexpr size_t MiB = 1u << 20;
constexpr size_t WS_CTL = 0, CTL_ZERO_BYTES = 1 * MiB;
constexpr size_t WS_WINT = 2 * MiB;
constexpr size_t WS_WOUTT = 15 * MiB;
constexpr size_t WS_WGLUT = 19 * MiB;
constexpr size_t WS_ROTC = 19 * MiB + 512 * 1024;
constexpr size_t WS_ROTS = 20 * MiB;
constexpr size_t WS_S5AB = 20 * MiB + 512 * 1024;
constexpr size_t WS_S5BB = 20 * MiB + 768 * 1024;
constexpr size_t WS_LB = 21 * MiB + 512 * 1024;
constexpr size_t WS_DT = 22 * MiB;
constexpr size_t WS_MSQ = 22 * MiB + 512 * 1024;
constexpr size_t WS_XB = 24 * MiB;
constexpr size_t WS_MIXED = 57 * MiB;
constexpr size_t WS_GY = 90 * MiB;
constexpr size_t WS_PROJ = 100 * MiB;
constexpr size_t WS_ZB = 206 * MiB;
constexpr size_t WS_S5APOW = 21 * MiB;
constexpr size_t WS_S5BBH = 21 * MiB + 256 * 1024;
constexpr size_t WS_S5CXH = 21 * MiB + 384 * 1024;
constexpr size_t WS_S5A256 = 21 * MiB + 576 * 1024;
constexpr size_t WS_END = 256 * MiB;
constexpr int CW_BAR = 4096;
constexpr int RING_OFF = 0, RING_BYTES = 131072;
constexpr int LDS_BYTES = 163840;
constexpr int LDSCTL_OFF = LDS_BYTES - 512, MISC_OFF = LDSCTL_OFF + 320;

#define GAS __attribute__((address_space(1)))
#define LAS __attribute__((address_space(3)))
#define DI __device__ __forceinline__
typedef unsigned short bf16;
typedef unsigned v4u __attribute__((ext_vector_type(4)));
typedef unsigned v2u __attribute__((ext_vector_type(2)));
typedef float f32x4 __attribute__((ext_vector_type(4)));
typedef GAS unsigned gu32;
#define RLX_AGENT __ATOMIC_RELAXED, __HIP_MEMORY_SCOPE_AGENT
#define LDS_WAIT() asm volatile("s_waitcnt lgkmcnt(0)" ::: "memory")
#define VM_WAIT() asm volatile("s_waitcnt vmcnt(0)" ::: "memory")
DI unsigned f2bf(float f) { unsigned u = __builtin_bit_cast(unsigned, f); return (u + 0x7fffu + ((u >> 16) & 1u)) >> 16; }
DI unsigned pk2(float lo, float hi) { return f2bf(lo) | (f2bf(hi) << 16); }
using pg8::bf2f; using pg8::ex2; using pg8::fexp; using pg8::sigm; using pg8::silu;

#define XB_TMO      128
#define XB_XCNT(j)  (256  + 64 * (j))
#define XB_XSUB(j)  (1280 + 64 * (j))
#define XB_XGEN(j)  (2304 + 64 * (j))
#define XB_TOP      3328
#define XB_TOPGEN   3392
#define XCD_BAR_WORDS 3456
#define XB_SPIN_CAP (1u << 18)

__device__ __forceinline__ unsigned xb_ld(unsigned* p)              { return __hip_atomic_load(p, __ATOMIC_RELAXED, __HIP_MEMORY_SCOPE_AGENT); }
__device__ __forceinline__ unsigned xb_add(unsigned* p, unsigned v) { return __hip_atomic_fetch_add(p, v, __ATOMIC_RELAXED, __HIP_MEMORY_SCOPE_AGENT); }
__device__ __forceinline__ unsigned xb_xcc_id() { return (unsigned)__builtin_amdgcn_s_getreg((3 << 11) | 20) & 0xFu; }
#define XB_SPIN(cond, bar) do { unsigned _sp = 0; while (cond) { __builtin_amdgcn_s_sleep(1); \
    if ((++_sp & 255u) == 0u) { if (xb_ld(&(bar)[XB_TMO])) break; if (_sp > XB_SPIN_CAP) { atomicAdd(&(bar)[XB_TMO], 1u); break; } } } } while (0)

struct XcdBarrier {
    unsigned* bar; unsigned x;
    volatile LAS unsigned* st;
};

__device__ __forceinline__ XcdBarrier xcd_barrier_post(unsigned* bar, volatile LAS unsigned* st) {
    XcdBarrier b; b.bar = bar; b.x = xb_xcc_id(); b.st = st;
    if (threadIdx.x == 0) (void)xb_add(&bar[XB_XCNT(b.x)], 1u);
    return b;
}
__device__ __forceinline__ void xcd_barrier_complete(unsigned* bar, unsigned x, unsigned& nloc, unsigned& nx) {
    const unsigned G = gridDim.x * gridDim.y * gridDim.z;
    unsigned sum, cnt, mine, sp = 0u;
    for (;;) {
        sum = 0u; cnt = 0u; mine = 0u;
#pragma unroll
        for (unsigned j = 0; j < 16; ++j) { const unsigned c = xb_ld(&bar[XB_XCNT(j)]); sum += c; cnt += (c > 0u) ? 1u : 0u; mine = (j == x) ? c : mine; }
        if (sum == G) break;
        __builtin_amdgcn_s_sleep(1);
        if ((++sp & 255u) == 0u) { if (xb_ld(&bar[XB_TMO])) break; if (sp > XB_SPIN_CAP) { atomicAdd(&bar[XB_TMO], 1u); break; } }
    }
    nloc = mine > 0u ? mine : 1u; nx = cnt > 0u ? cnt : 1u;
}

__device__ __forceinline__ void xcd_barrier(const XcdBarrier& b) {
    asm volatile("s_waitcnt vmcnt(0)" ::: "memory");
    __syncthreads();
    if (threadIdx.x == 0) {
        unsigned* bar = b.bar;
        __builtin_amdgcn_s_waitcnt(0);
        unsigned nloc = b.st[0], nx = b.st[1];
        if (nloc == 0u) { xcd_barrier_complete(bar, b.x, nloc, nx); b.st[0] = nloc; b.st[1] = nx; }
        const unsigned old = xb_add(&bar[XB_XSUB(b.x)], 1u);
        const unsigned gen = old / nloc;
        if (old + 1u == (gen + 1u) * nloc) {
            __builtin_amdgcn_fence(__ATOMIC_RELEASE, "agent");
            asm volatile("s_waitcnt vmcnt(0)" ::: "memory");
            const unsigned og = xb_add(&bar[XB_TOP], 1u);
            const unsigned tg = og / nx;
            if (og + 1u == (tg + 1u) * nx) xb_add(&bar[XB_TOPGEN], 1u);
            else XB_SPIN(xb_ld(&bar[XB_TOPGEN]) == tg, bar);
            __builtin_amdgcn_fence(__ATOMIC_ACQUIRE, "agent");
            xb_add(&bar[XB_XGEN(b.x)], 1u);
            asm volatile("s_waitcnt vmcnt(0)" ::: "memory");
        } else {
            XB_SPIN(xb_ld(&bar[XB_XGEN(b.x)]) == gen, bar);
            __builtin_amdgcn_fence(__ATOMIC_ACQUIRE, "agent");
            asm volatile("s_waitcnt vmcnt(0)" ::: "memory");
        }
    }
    __syncthreads();
}

struct Args { const float* in[31]; float* out; unsigned char* ws; int ph_lo, ph_hi, li, pad; };
struct Frame {
    LAS unsigned char* lds; volatile LAS unsigned* MISC; gu32* ctl;
    int tid, lane, wave, vcu, G, bx;
    const float* const* ka; float* out_; unsigned char* ws_;
};
DI const float* INP(const Frame& F, int i) { const float* const* t = F.ka; asm volatile("" : "+s"(t)); return t[i]; }
DI unsigned char* WSP(const Frame& F) { unsigned char* w = F.ws_; asm volatile("" : "+s"(w)); return w; }
DI float* OUTP(const Frame& F) { float* o = F.out_; asm volatile("" : "+s"(o)); return o; }
DI float wave_sum(float v) {
#pragma unroll
    for (int o = 1; o < 64; o <<= 1) v += __shfl_xor(v, o);
    return v;
}
DI void sincos_acc(float ang, float& s, float& c) {
    const float C1 = 0.15915493667125702f, C2 = 6.4206382432985265e-09f;
    const float hi = ang * C1, lo = __builtin_fmaf(ang, C1, -hi) + ang * C2;
    const float f = (hi - __builtin_rintf(hi)) + lo;
    const float qf = __builtin_rintf(4.f * f); const int q = (int)qf;
    const float u = __builtin_fmaf(-0.25f, qf, f);
    const float r = __builtin_fmaf(u, 6.2831854820251465f, u * -1.7484555314695172e-07f);
    const float r2 = r * r;
    float sp = 2.7557319e-06f; sp = __builtin_fmaf(sp, r2, -1.9841270e-04f); sp = __builtin_fmaf(sp, r2, 8.3333333e-03f); sp = __builtin_fmaf(sp, r2, -1.6666667e-01f);
    const float sn = __builtin_fmaf(r * r2, sp, r);
    float cp = -2.7557319e-07f; cp = __builtin_fmaf(cp, r2, 2.4801587e-05f); cp = __builtin_fmaf(cp, r2, -1.3888889e-03f); cp = __builtin_fmaf(cp, r2, 4.1666667e-02f); cp = __builtin_fmaf(cp, r2, -0.5f);
    const float cs = __builtin_fmaf(r2, cp, 1.f);
    const int qq = q & 3;
    s = qq == 0 ? sn : qq == 1 ? cs : qq == 2 ? -sn : -cs;
    c = qq == 0 ? cs : qq == 1 ? -sn : qq == 2 ? -cs : sn;
}
__device__ __constant__ float ROT_INV[32] = {1.000000000e+00f, 7.498942018e-01f, 5.623413324e-01f, 4.216965139e-01f, 3.162277639e-01f, 2.371373773e-01f, 1.778279394e-01f, 1.333521456e-01f, 1.000000015e-01f, 7.498942316e-02f, 5.623413250e-02f, 4.216964915e-02f, 3.162277490e-02f, 2.371373773e-02f, 1.778279431e-02f, 1.333521400e-02f, 9.999999776e-03f, 7.498942316e-03f, 5.623413250e-03f, 4.216964822e-03f, 3.162277630e-03f, 2.371373819e-03f, 1.778279431e-03f, 1.333521446e-03f, 1.000000047e-03f, 7.498941850e-04f, 5.623413017e-04f, 4.216965172e-04f, 3.162277571e-04f, 2.371373703e-04f, 1.778279402e-04f, 1.333521504e-04f};
DI void transpose_item(const float* W, int K, int ld, int nblk, bf16* WT, LAS float* scr, int item, int lane) {
    const int kb = item / nblk, nb = item % nblk, k0 = 64 * kb, n0 = 32 * nb;
#pragma unroll 8
    for (int i = 0; i < 32; ++i) { const int kk = 2 * i + (lane >> 5); scr[kk * 33 + (lane & 31)] = W[(size_t)(k0 + kk) * ld + n0 + (lane & 31)]; }
    LDS_WAIT(); asm volatile("" ::: "memory");
    const int c = lane & 7;
#pragma unroll
    for (int j = 0; j < 4; ++j) { const int n = (lane >> 3) + 8 * j; const LAS float* s = scr + (8 * c) * 33 + n;
        v4u o; o.x = pk2(s[0 * 33], s[1 * 33]); o.y = pk2(s[2 * 33], s[3 * 33]); o.z = pk2(s[4 * 33], s[5 * 33]); o.w = pk2(s[6 * 33], s[7 * 33]);
        *(GAS v4u*)(WT + (size_t)(n0 + n) * K + k0 + 8 * c) = o; }
    LDS_WAIT(); asm volatile("" ::: "memory");
}
DI void aprep(Frame& F, int layer) {
    LAS f32x4* wdt = (LAS f32x4*)(F.lds + RING_OFF);
    const float* Win = INP(F, 9) + (size_t)layer * DM * NPROJ_FULL;
    for (int k = F.tid; k < DM; k += NTHR) wdt[k] = *(const f32x4*)(Win + (size_t)k * NPROJ_FULL + NPROJ);
    __syncthreads();
    const float* nw = INP(F, 8) + layer * DM;
    bf16* XB = (bf16*)(WSP(F) + WS_XB); float* DT = (float*)(WSP(F) + WS_DT);
    const int gw = F.vcu * NWAVES + F.wave, NGW = F.G * NWAVES, lane = F.lane;
    f32x4 nwv[4];
#pragma unroll
    for (int j = 0; j < 4; ++j) nwv[j] = *((const f32x4*)nw + lane + 64 * j);
    for (int m = gw; m < MPAD; m += NGW) {
        GAS unsigned long long* o8 = (GAS unsigned long long*)(XB + (size_t)m * DM) + lane;
        if (m >= MVALID) {
#pragma unroll
            for (int j = 0; j < 4; ++j) o8[64 * j] = 0ull;
            continue; }
        const float* src = layer == 0 ? (m < MPROMPT ? INP(F, 0) + (size_t)m * DM : INP(F, 1) + (size_t)(m - MPROMPT) * DM) : OUTP(F) + (size_t)m * DM;
        const f32x4* xr = (const f32x4*)src + lane;
        f32x4 v[4]; float ss = 0.f;
#pragma unroll
        for (int j = 0; j < 4; ++j) { v[j] = xr[64 * j]; ss += (v[j].x * v[j].x + v[j].y * v[j].y) + (v[j].z * v[j].z + v[j].w * v[j].w); }
        const float rstd = 1.f / sqrtf(wave_sum(ss) * (1.f / DM) + EPS);
        f32x4 d = (f32x4){0.f, 0.f, 0.f, 0.f};
#pragma unroll
        for (int j = 0; j < 4; ++j) { v[j] = v[j] * rstd * nwv[j];
            const int k = 4 * (lane + 64 * j);
            d += wdt[k] * v[j].x; d += wdt[k + 1] * v[j].y; d += wdt[k + 2] * v[j].z; d += wdt[k + 3] * v[j].w;
            o8[64 * j] = (unsigned long long)pk2(v[j].x, v[j].y) | ((unsigned long long)pk2(v[j].z, v[j].w) << 32); }
        d.x = wave_sum(d.x); d.y = wave_sum(d.y); d.z = wave_sum(d.z); d.w = wave_sum(d.w);
        if (lane == 0) *(f32x4*)(DT + (size_t)m * 4) = d;
    }
}
DI void final_norm(Frame& F) {
    const float* fw = INP(F, 30);
    const int gw = F.vcu * NWAVES + F.wave, NGW = F.G * NWAVES, lane = F.lane;
    f32x4 nwv[4];
#pragma unroll
    for (int j = 0; j < 4; ++j) nwv[j] = *((const f32x4*)fw + lane + 64 * j);
    for (int m = gw; m < MVALID; m += NGW) {
        f32x4* xr = (f32x4*)(OUTP(F) + (size_t)m * DM) + lane;
        f32x4 v[4]; float ss = 0.f;
#pragma unroll
        for (int j = 0; j < 4; ++j) { v[j] = xr[64 * j]; ss += (v[j].x * v[j].x + v[j].y * v[j].y) + (v[j].z * v[j].z + v[j].w * v[j].w); }
        const float rstd = 1.f / sqrtf(wave_sum(ss) * (1.f / DM) + EPS);
#pragma unroll
        for (int j = 0; j < 4; ++j) xr[64 * j] = v[j] * rstd * nwv[j];
    }
}
DI void prologue(Frame& F) {
    LAS float* scr = (LAS float*)(F.lds + RING_OFF + 16384 + F.wave * 12288);
    const int gw = F.vcu * NWAVES + F.wave, NGW = F.G * NWAVES;
    constexpr int I_IN = 16 * 104, I_OUT = 16 * 32, I_GLU = 4 * 8, I_L = I_IN + I_OUT + I_GLU;
    for (int it = gw; it < 2 * I_L; it += NGW) {
        const int l = it / I_L; int r = it % I_L;
        if (r < I_IN) { transpose_item(INP(F, 9) + (size_t)l * DM * NPROJ_FULL, DM, NPROJ_FULL, 104, (bf16*)(WSP(F) + WS_WINT) + (size_t)l * NPROJ * DM, scr, r, F.lane); continue; } r -= I_IN;
        if (r < I_OUT) { transpose_item(INP(F, 29) + (size_t)l * DM * DM, DM, DM, 32, (bf16*)(WSP(F) + WS_WOUTT) + (size_t)l * DM * DM, scr, r, F.lane); continue; } r -= I_OUT;
        transpose_item(INP(F, 21) + (size_t)l * 65536, 256, 256, 8, (bf16*)(WSP(F) + WS_WGLUT) + (size_t)l * 65536, scr, r, F.lane);
    }
    const int gt = F.vcu * NTHR + F.tid, NGT = F.G * NTHR;
    float* RC = (float*)(WSP(F) + WS_ROTC); float* RS = (float*)(WSP(F) + WS_ROTS);
    for (int idx = gt; idx < 2049 * 32; idx += NGT) {
        const int p = idx >> 5, i = idx & 31; const float pos = p < 2048 ? (float)p : 16384.f;
        const float ang = pos * ROT_INV[i];
        float s, c; sincos_acc(ang, s, c); RC[idx] = c; RS[idx] = s;
    }
    float* AB = (float*)(WSP(F) + WS_S5AB); float* BB = (float*)(WSP(F) + WS_S5BB); float* APW = (float*)(WSP(F) + WS_S5APOW); float* A2 = (float*)(WSP(F) + WS_S5A256); bf16* BBH = (bf16*)(WSP(F) + WS_S5BBH);
    for (int idx = gt; idx < 2 * 16 * 64; idx += NGT) {
        const int l = idx >> 10, g = (idx >> 6) & 15;
        const float are = INP(F, 13)[idx], aim = INP(F, 14)[idx], dt = expf(INP(F, 15)[l * 16 + g]);
        const float mag = expf(are * dt); float s, c; sincos_acc(aim * dt, s, c);
        const float abr = mag * c, abi = mag * s; AB[2 * idx] = abr; AB[2 * idx + 1] = abi;
        const float nr = abr - 1.f, ni = abi, den = are * are + aim * aim;
        const float fr = (nr * are + ni * aim) / den, fi = (ni * are - nr * aim) / den;
        for (int cc = 0; cc < 16; ++cc) { const float br = INP(F, 16)[(size_t)idx * 16 + cc], bi = INP(F, 17)[(size_t)idx * 16 + cc];
            const float bbr = fr * br - fi * bi, bbi = fr * bi + fi * br;
            BB[((size_t)idx * 16 + cc) * 2] = bbr; BB[((size_t)idx * 16 + cc) * 2 + 1] = bbi;
            BBH[((size_t)(((idx >> 6) * 2 + 0) * 64 + (idx & 63))) * 16 + cc] = (bf16)f2bf(bbr); BBH[((size_t)(((idx >> 6) * 2 + 1) * 64 + (idx & 63))) * 16 + cc] = (bf16)f2bf(bbi); }
        { float pr = abr, pi = abi;
          for (int i = 0; i < 16; ++i) { APW[((size_t)idx * 16 + i) * 2] = pr; APW[((size_t)idx * 16 + i) * 2 + 1] = pi; const float nr = pr * abr - pi * abi, ni = pr * abi + pi * abr; pr = nr; pi = ni; }
          float sr = abr, si = abi;
          for (int k = 0; k < 8; ++k) { const float nr = sr * sr - si * si, ni = 2.f * sr * si; sr = nr; si = ni; }
          A2[2 * idx] = sr; A2[2 * idx + 1] = si; }
    }
    { bf16* CXH = (bf16*)(WSP(F) + WS_S5CXH);
      for (int idx = gt; idx < 2 * 16 * 16 * 128; idx += NGT) { const int k = idx & 127, row = idx >> 7;
          CXH[idx] = (bf16)f2bf(k < 64 ? INP(F, 18)[(size_t)row * 64 + k] : -INP(F, 19)[(size_t)row * 64 + k - 64]); } }
    float* LB = (float*)(WSP(F) + WS_LB);
    for (int idx = gt; idx < 256; idx += NGT) {
        const float l0 = INP(F, 11)[idx], l1 = INP(F, 11)[256 + idx], mx = fmaxf(l0, l1), e0 = expf(l0 - mx), e1 = expf(l1 - mx);
        const float s0 = e0 / (e0 + e1), s1 = e1 / (e0 + e1);
        LB[idx] = fminf(fmaxf(s0 - s0, 0.f), 1.f); LB[256 + idx] = fminf(fmaxf((s0 + s1) - s0, 0.f), 1.f);
    }
    __syncthreads();
    aprep(F, 0);
}
DI float gelu_tanh(float x) { const float u = 0.7978845608028654f * (x + 0.044715f * x * x * x); const float t = 1.f - 2.f / (1.f + fexp(2.f * u)); return 0.5f * x * (1.f + t); }
DI float softplus(float x) { return fmaxf(x, 0.f) + log1pf(expf(-fabsf(x))); }
DI void linrec_unit(Frame& F, int layer, int branch, int h, int row0, int ntok, int rot0, const float* h0, float* hout, const float* cb0, float* cbout) {
    LAS float* Q = (LAS float*)(F.lds + RING_OFF); LAS float* K = Q + 4096; LAS float* V = K + 4096; LAS float* A = V + 4096; LAS float* O = A + 4096; LAS float* Gt = O + 4096; LAS float* X = Gt + 4096;
    const bf16* P = (const bf16*)(WSP(F) + WS_PROJ); bf16* MX = (bf16*)(WSP(F) + WS_MIXED);
    const float* RC = (const float*)(WSP(F) + WS_ROTC); const float* RS = (const float*)(WSP(F) + WS_ROTS); const float* LB = (const float*)(WSP(F) + WS_LB) + layer * 256;
    const float* DT = (const float*)(WSP(F) + WS_DT); float* MSQ = (float*)(WSP(F) + WS_MSQ);
    int tid_ = F.tid; asm volatile("" : "+v"(tid_));
    const int tid = tid_, w = __builtin_amdgcn_readfirstlane(tid >> 6), lane = tid & 63, vi = lane & 7, kg = lane >> 3, v = 8 * w + vi;
    float hs[8];
#pragma unroll
    for (int j = 0; j < 8; ++j) hs[j] = h0 ? h0[(8 * kg + j) * 64 + v] : 0.f;
    const float gamma = 1.f - ex2(-5.f - (float)h);
    const float* cw = INP(F, 23) + layer * 2048; const float* cbias = INP(F, 24) + layer * 512;
    const float dtb = INP(F, 25)[layer * 4 + h], Ah = -expf(INP(F, 26)[layer * 4 + h]), Dh = INP(F, 27)[layer * 4 + h];
    const int g2 = h >> 1;
    for (int c0 = 0; c0 < ntok; c0 += 64) {
        const int nt = (ntok - c0) < 64 ? (ntok - c0) : 64;
        __syncthreads();
        for (int e = tid; e < 4096; e += NTHR) {
            const int t = e >> 6, ch = e & 63; if (t >= nt) continue;
            const size_t r = (size_t)(row0 + c0 + t); const bf16* pr = P + r * NPROJ;
            if (branch == 0) {
                const int i = ch & 31; const float cs = RC[(rot0 + c0 + t) * 32 + i], sn = RS[(rot0 + c0 + t) * 32 + i];
                const float q1 = bf2f(pr[h * 64 + i]), q2 = bf2f(pr[h * 64 + 32 + i]), k1 = bf2f(pr[256 + h * 64 + i]), k2 = bf2f(pr[256 + h * 64 + 32 + i]);
                Q[e] = ch < 32 ? q1 * cs - q2 * sn : q1 * sn + q2 * cs;
                K[e] = (ch < 32 ? k1 * cs - k2 * sn : k1 * sn + k2 * cs) * 0.125f;
                V[e] = bf2f(pr[512 + h * 64 + ch]); A[e] = gamma; Gt[e] = bf2f(pr[768 + h * 64 + ch]);
            } else if (branch == 1) {
                const float fr = bf2f(pr[1280 + h * 64 + ch]), lb = LB[h * 64 + ch], sg = sigm(fr);
                Q[e] = silu(bf2f(pr[1024 + h * 64 + ch])); A[e] = lb + (1.f - lb) * sg; K[e] = (1.f - lb) * sigm(-fr);
                V[e] = bf2f(pr[1536 + h * 64 + ch]); Gt[e] = bf2f(pr[1792 + h * 64 + ch]);
            } else {
                const int cx = h * 64 + ch, cB = 256 + g2 * 64 + ch, cC = 384 + g2 * 64 + ch;
                float ax = cbias[cx], aB = cbias[cB], aC = cbias[cC];
#pragma unroll
                for (int i = 0; i < 4; ++i) { const int tt = c0 + t - 3 + i; float rx, rB, rC;
                    if (tt >= 0) { const bf16* p2 = P + (size_t)(row0 + tt) * NPROJ + 2816; rx = bf2f(p2[cx]); rB = bf2f(p2[cB]); rC = bf2f(p2[cC]); }
                    else if (cb0) { rx = cb0[(3 + tt) * 512 + cx]; rB = cb0[(3 + tt) * 512 + cB]; rC = cb0[(3 + tt) * 512 + cC]; }
                    else { rx = 0.f; rB = 0.f; rC = 0.f; }
                    ax += cw[i * 512 + cx] * rx; aB += cw[i * 512 + cB] * rB; aC += cw[i * 512 + cC] * rC; }
                const float xc = silu(ax), dt = softplus(DT[r * 4 + h] + dtb);
                Q[e] = silu(aC); K[e] = silu(aB); V[e] = xc * dt; A[e] = expf(dt * Ah); X[e] = xc; Gt[e] = bf2f(pr[2560 + h * 64 + ch]);
            }
        }
        __syncthreads();
        for (int t = 0; t < nt; ++t) {
            const LAS float* q = Q + t * 64 + 8 * kg; const LAS float* k = K + t * 64 + 8 * kg; const LAS float* a = A + t * 64 + 8 * kg; const float vv = V[t * 64 + v];
            float p = 0.f;
#pragma unroll
            for (int j = 0; j < 8; ++j) { hs[j] = a[j] * hs[j] + k[j] * vv; p += q[j] * hs[j]; }
            p += __shfl_xor(p, 8); p += __shfl_xor(p, 16); p += __shfl_xor(p, 32);
            if (kg == 0) O[t * 64 + v] = p;
        }
        __syncthreads();
        {
            const int t = tid >> 3, sub = tid & 7; const size_t r = (size_t)(row0 + c0 + t);
            float o[8]; float ss = 0.f;
#pragma unroll
            for (int j = 0; j < 8; ++j) { const int e = t * 64 + sub * 8 + j; float x = O[e]; if (branch == 2) x = (x + Dh * X[e]) * silu(Gt[e]); o[j] = x; ss += x * x; }
            ss += __shfl_xor(ss, 1); ss += __shfl_xor(ss, 2); ss += __shfl_xor(ss, 4);
            if (t < nt) {
                if (branch != 2) { const float sc = 1.f / sqrtf(ss * (1.f / 64.f) + EPS); const float* nw = INP(F, branch == 0 ? 10 : 12) + layer * 256 + h * 64 + sub * 8;
#pragma unroll
                    for (int j = 0; j < 8; ++j) o[j] = o[j] * sc * nw[j] * silu(Gt[t * 64 + sub * 8 + j]); }
                else if (sub == 0) MSQ[r * 4 + h] = ss;
                v4u wv; wv.x = pk2(o[0], o[1]); wv.y = pk2(o[2], o[3]); wv.z = pk2(o[4], o[5]); wv.w = pk2(o[6], o[7]);
                *(v4u*)(MX + r * DM + branch * 256 + (branch == 2 ? 256 : 0) + h * 64 + sub * 8) = wv;
            }
        }
    }
#pragma unroll
    for (int j = 0; j < 8; ++j) hout[(8 * kg + j) * 64 + v] = hs[j];
    if (branch == 2 && h == 0) {
        for (int e = tid; e < 1536; e += NTHR) { const int i = e / 512, cc = e % 512, tt = ntok - 3 + i;
            cbout[e] = tt >= 0 ? bf2f(P[(size_t)(row0 + tt) * NPROJ + 2816 + cc]) : (cb0 ? cb0[(3 + tt) * 512 + cc] : 0.f); }
    }
}
DI void s5_unit(Frame& F, int layer, int g, int row0, int ntok, const float* h0r, const float* h0i, float* hor, float* hoi) {
    LAS float* U = (LAS float*)(F.lds + RING_OFF); LAS float* H = U + 1024; LAS float* Cr = H + 8192; LAS float* Ci = Cr + 1024;
    const bf16* P = (const bf16*)(WSP(F) + WS_PROJ); bf16* GY = (bf16*)(WSP(F) + WS_GY);
    int tid_ = F.tid; asm volatile("" : "+v"(tid_)); const int tid = tid_;
    __syncthreads();
    for (int e = tid; e < 1024; e += NTHR) { Cr[e] = INP(F, 18)[(size_t)(layer * 16 + g) * 1024 + e]; Ci[e] = INP(F, 19)[(size_t)(layer * 16 + g) * 1024 + e]; }
    float hr = 0.f, hi = 0.f, abr = 0.f, abi = 0.f; float bbr[16], bbi[16];
    if (tid < 64) { const int idx = (layer * 16 + g) * 64 + tid; const float* AB = (const float*)(WSP(F) + WS_S5AB); const float* BB = (const float*)(WSP(F) + WS_S5BB);
        abr = AB[2 * idx]; abi = AB[2 * idx + 1];
#pragma unroll
        for (int c = 0; c < 16; ++c) { bbr[c] = BB[((size_t)idx * 16 + c) * 2]; bbi[c] = BB[((size_t)idx * 16 + c) * 2 + 1]; }
        if (h0r) { hr = h0r[tid]; hi = h0i[tid]; } }
    const float* Dv = INP(F, 20) + layer * 256 + g * 16;
    for (int c0 = 0; c0 < ntok; c0 += 64) {
        const int nt = (ntok - c0) < 64 ? (ntok - c0) : 64;
        __syncthreads();
        for (int e = tid; e < 1024; e += NTHR) { const int t = e >> 4, c = e & 15; if (t < nt) U[e] = bf2f(P[(size_t)(row0 + c0 + t) * NPROJ + 2048 + g * 16 + c]); }
        __syncthreads();
        if (tid < 64) {
            for (int t = 0; t < nt; ++t) {
                float br = 0.f, bi = 0.f;
#pragma unroll
                for (int c = 0; c < 16; ++c) { const float u = U[t * 16 + c]; br += bbr[c] * u; bi += bbi[c] * u; }
                const float nr = abr * hr - abi * hi + br, ni = abr * hi + abi * hr + bi; hr = nr; hi = ni;
                H[(t * 64 + tid) * 2] = hr; H[(t * 64 + tid) * 2 + 1] = hi;
            }
        }
        __syncthreads();
        for (int e = tid; e < 1024; e += NTHR) { const int t = e >> 4, c = e & 15; if (t >= nt) continue;
            float y = 0.f;
            for (int p = 0; p < 64; ++p) y += Cr[c * 64 + p] * H[(t * 64 + p) * 2] - Ci[c * 64 + p] * H[(t * 64 + p) * 2 + 1];
            const float sy = y + Dv[c] * U[e];
            GY[(size_t)(row0 + c0 + t) * 256 + g * 16 + c] = (bf16)f2bf(gelu_tanh(sy)); }
    }
    if (tid < 64) { hor[tid] = hr; hoi[tid] = hi; }
}

typedef short bf16x8 __attribute__((ext_vector_type(8)));
typedef short s16x4 __attribute__((ext_vector_type(4)));
typedef short v4i16_t __attribute__((ext_vector_type(4)));
typedef float f32x16 __attribute__((ext_vector_type(16)));
typedef float f32x2v __attribute__((ext_vector_type(2)));
typedef __bf16 bf16x2v __attribute__((ext_vector_type(2)));
DI unsigned cvtpk(float lo, float hi) { f32x2v v = {lo, hi}; bf16x2v b = __builtin_convertvector(v, bf16x2v); return __builtin_bit_cast(unsigned, b); }
DI int crow(int i, int hh) { return (i & 3) + 8 * (i >> 2) + 4 * hh; }
#define MFMA32(a, b, c) __builtin_amdgcn_mfma_f32_32x32x16_bf16((a), (b), (c), 0, 0, 0)
constexpr int TP = 144, TILE_B = 64 * TP;
constexpr int VEC_OFF = 12 * TILE_B;
DI int toff(int row, int col) { return row * TP + col * 2; }
DI bf16x8 ld128(LAS unsigned char* p) { return *(LAS bf16x8*)p; }
DI s16x4 ld64(LAS unsigned char* p) { return *(LAS s16x4*)p; }
DI s16x4 ldtr(LAS unsigned char* p) { return __builtin_bit_cast(s16x4, __builtin_amdgcn_ds_read_tr16_b64_v4i16((LAS v4i16_t*)p)); }
DI bf16x8 cat8(s16x4 lo, s16x4 hi) { return __builtin_shufflevector(lo, hi, 0, 1, 2, 3, 4, 5, 6, 7); }
template <int ST> DI bf16x8 packacc(const f32x16& x) {
    v4u p; p.x = cvtpk(x[8 * ST], x[8 * ST + 1]); p.y = cvtpk(x[8 * ST + 2], x[8 * ST + 3]); p.z = cvtpk(x[8 * ST + 4], x[8 * ST + 5]); p.w = cvtpk(x[8 * ST + 6], x[8 * ST + 7]);
    return __builtin_bit_cast(bf16x8, p);
}
template <bool PERM> DI bf16x8 trfrag(LAS unsigned char* tile, int R0  , int C0, int lane) {
    const int hh = lane >> 5, q = (lane & 15) >> 2, p = lane & 3, blk = (lane >> 4) & 1;
    const int rlo = PERM ? R0 + 4 * hh + q : R0 + 8 * hh + q, rhi = PERM ? rlo + 8 : rlo + 4;
    const int col = C0 + 16 * blk + 4 * p;
    return cat8(ldtr(tile + toff(rlo, col)), ldtr(tile + toff(rhi, col)));
}
constexpr size_t WS_SLOC = 210 * MiB;
constexpr size_t WS_DTOT = 223 * MiB;
constexpr size_t WS_S5LOC = 224 * MiB;

template <int BR, bool OUT> DI void lin_unit(Frame& F, int l, int pm) {
    LAS unsigned char* L = F.lds;
    unsigned char* ws = WSP(F);
    const bf16* PJ = (const bf16*)(ws + WS_PROJ); bf16* MX = (bf16*)(ws + WS_MIXED);
    float* SLOC = (float*)(ws + WS_SLOC); float* DTOT = (float*)(ws + WS_DTOT);
    int tid_ = F.tid; asm volatile("" : "+v"(tid_));
    const int tid = tid_, lane = tid & 63, wv = __builtin_amdgcn_readfirstlane(tid >> 6), hd = wv >> 1, th = wv & 1, r = lane & 31, hh = lane >> 5;
    const int b = pm >> 3, sc = pm & 7, hid = BR * 4 + hd;
    const size_t row0 = (size_t)pm * 256;
    LAS unsigned char* Qt = L + (BR == 2 ? (2 * (hd >> 1)) : 3 * hd) * TILE_B;
    LAS unsigned char* Kt = L + (BR == 2 ? (2 * (hd >> 1) + 1) : 3 * hd + 1) * TILE_B;
    LAS unsigned char* Vt = L + (BR == 2 ? (4 + 2 * hd) : 3 * hd + 2) * TILE_B;
    LAS unsigned char* Wt = L + (5 + 2 * hd) * TILE_B;
    LAS float* ECM = (LAS float*)(L + VEC_OFF); LAS float* ETL = ECM + 256;
    LAS float* CUM = ETL + 256; LAS float* DTS = CUM + 256; LAS float* DTW = DTS + 256; LAS float* LA = DTW + 256; LAS float* SSQ = LA + 256; LAS float* TOT = SSQ + 256;
    f32x16 H[2][2];
#pragma unroll
    for (int a = 0; a < 2; ++a)
#pragma unroll
        for (int c = 0; c < 2; ++c)
#pragma unroll
            for (int i = 0; i < 16; ++i) H[a][c][i] = 0.f;
#ifndef X_NOINIT
    if (OUT) {
        for (int j = 0; j < sc; ++j) {
            const size_t u = (size_t)((pm - sc + j) * 12 + hid);
#pragma unroll
            for (int ki = 0; ki < 2; ++ki)
#pragma unroll
                for (int i = 0; i < 16; ++i) { const int k = 32 * ki + crow(i, hh); const float d = ex2(DTOT[u * 64 + k]);
#pragma unroll
                    for (int vj = 0; vj < 2; ++vj) H[ki][vj][i] = H[ki][vj][i] * d + SLOC[(u * 64 + k) * 64 + 32 * vj + r];
                    if ((i & 3) == 3) __builtin_amdgcn_sched_barrier(0); }
        }
    }
#endif
    float dsum = 0.f;
    const float lg2 = BR == 0 ? __builtin_amdgcn_logf(1.f - ex2(-5.f - (float)hd)) : 0.f;
#pragma unroll 1
    for (int c = 0; c < 4; ++c) {
        const size_t rowc = row0 + 64 * c;
        if (BR == 0) {
            const int li = th * 64 + lane;
            const float* RC = (const float*)(ws + WS_ROTC); const float* RS = (const float*)(ws + WS_ROTS);
#pragma unroll
            for (int which = 0; which < 2; ++which) {
                if (which == 0 && !OUT) continue;
#pragma unroll
                for (int j = 0; j < 2; ++j) { const int tk = li + 128 * j, t = tk >> 2, c0 = 8 * (tk & 3);
                    const bf16* src = PJ + (rowc + t) * NPROJ + which * 256 + hd * 64 + c0;
                    const v4u xa = *(const v4u*)src, xb = *(const v4u*)(src + 32);
                    const int pos = sc * 256 + c * 64 + t;
                    const f32x4 cs0 = *(const f32x4*)(RC + pos * 32 + c0), cs1 = *(const f32x4*)(RC + pos * 32 + c0 + 4), sn0 = *(const f32x4*)(RS + pos * 32 + c0), sn1 = *(const f32x4*)(RS + pos * 32 + c0 + 4);
                    const float sc_ = which == 0 ? ex2((float)(t - 31) * lg2) : 0.125f * ex2((float)(31 - t) * lg2);
                    float lo[8], hi[8];
#pragma unroll
                    for (int e = 0; e < 8; ++e) { const unsigned wa = xa[e >> 1], wb = xb[e >> 1]; const float a = (e & 1) ? __uint_as_float(wa & 0xffff0000u) : __uint_as_float(wa << 16), bb = (e & 1) ? __uint_as_float(wb & 0xffff0000u) : __uint_as_float(wb << 16);
                        const float cs = e < 4 ? cs0[e & 3] : cs1[e & 3], sn = e < 4 ? sn0[e & 3] : sn1[e & 3];
                        lo[e] = (a * cs - bb * sn) * sc_; hi[e] = (a * sn + bb * cs) * sc_; }
                    v4u olo, ohi; olo.x = cvtpk(lo[0], lo[1]); olo.y = cvtpk(lo[2], lo[3]); olo.z = cvtpk(lo[4], lo[5]); olo.w = cvtpk(lo[6], lo[7]);
                    ohi.x = cvtpk(hi[0], hi[1]); ohi.y = cvtpk(hi[2], hi[3]); ohi.z = cvtpk(hi[4], hi[5]); ohi.w = cvtpk(hi[6], hi[7]);
                    LAS unsigned char* T = which == 0 ? Qt : Kt;
                    *(LAS v4u*)(T + toff(t, c0)) = olo; *(LAS v4u*)(T + toff(t, c0 + 32)) = ohi; }
                __builtin_amdgcn_sched_barrier(0);
            }
#pragma unroll
            for (int j = 0; j < 4; ++j) { const int id = li + 128 * j, t = id >> 3, pc = id & 7;
                *(LAS v4u*)(Vt + toff(t, 8 * pc)) = *(const v4u*)(PJ + (rowc + t) * NPROJ + 512 + hd * 64 + 8 * pc); }
            if (li < 64) { ECM[hd * 64 + li] = ex2(32.f * lg2); ETL[hd * 64 + li] = ex2(32.f * lg2); }
            dsum += 64.f * lg2;
        } else if (BR == 1) {
            const int k = lane, half = th;
            const float lb = ((const float*)(ws + WS_LB))[l * 256 + hd * 64 + k];
            const bf16* src = PJ + (rowc + 32 * half) * NPROJ + hd * 64 + k;
            float run[32]; float acc = 0.f;
#pragma unroll
            for (int t = 0; t < 32; ++t) { const float fr = bf2f(src[(size_t)t * NPROJ + 1280]); const float f = lb + (1.f - lb) * sigm(fr); acc += __builtin_amdgcn_logf(f); run[t] = acc; if ((t & 7) == 7) __builtin_amdgcn_sched_barrier(0); }
            const float tot = acc;
#pragma unroll
            for (int t = 0; t < 32; ++t) {
                const float fr = bf2f(src[(size_t)t * NPROJ + 1280]);
                const float eq = half == 0 ? run[t] - tot : run[t], ek = half == 0 ? tot - run[t] : -run[t];
                if (OUT) { const float gq = bf2f(src[(size_t)t * NPROJ + 1024]); *(LAS bf16*)(Qt + toff(32 * half + t, k)) = (bf16)f2bf(silu(gq) * ex2(eq)); }
                *(LAS bf16*)(Kt + toff(32 * half + t, k)) = (bf16)f2bf((1.f - lb) * sigm(-fr) * ex2(ek));
                *(LAS bf16*)(Vt + toff(32 * half + t, k)) = src[(size_t)t * NPROJ + 1536];
                if ((t & 3) == 3) __builtin_amdgcn_sched_barrier(0);
            }
            if (half == 0) ECM[hd * 64 + k] = ex2(tot); else ETL[hd * 64 + k] = ex2(tot);
            dsum += tot;
        } else {
            if (tid < 256) { const int t = tid >> 2, h = tid & 3; const float dtv = softplus(((const float*)(ws + WS_DT))[(rowc + t) * 4 + h] + INP(F, 25)[l * 4 + h]);
                DTS[h * 64 + t] = dtv; LA[h * 64 + t] = dtv * (-expf(INP(F, 26)[l * 4 + h])) * 1.4426950408889634f; }
            __syncthreads();
            if (wv == 0) {
#pragma unroll
                for (int h = 0; h < 4; ++h) { float v = LA[h * 64 + lane];
#pragma unroll
                    for (int o = 1; o < 64; o <<= 1) { const float u = __shfl_up(v, o); if (lane >= o) v += u; }
                    const float tot = __shfl(v, 63); CUM[h * 64 + lane] = v; DTW[h * 64 + lane] = DTS[h * 64 + lane] * ex2(tot - v); if (lane == 0) TOT[h] = tot; }
            }
            __syncthreads();
            { const int cc = tid; const float* cw = INP(F, 23) + l * 2048; const float w0 = cw[cc], w1 = cw[512 + cc], w2 = cw[1024 + cc], w3 = cw[1536 + cc], cb = INP(F, 24)[l * 512 + cc];
              const bf16* src = PJ + rowc * NPROJ + 2816 + cc; const int T0 = sc * 256 + c * 64;
              float x0 = T0 >= 3 ? bf2f(*(src - 3 * (ptrdiff_t)NPROJ)) : 0.f, x1 = T0 >= 2 ? bf2f(*(src - 2 * (ptrdiff_t)NPROJ)) : 0.f, x2 = T0 >= 1 ? bf2f(*(src - (ptrdiff_t)NPROJ)) : 0.f;
              const int role = cc >> 8 == 0 ? 0 : (cc < 384 ? 1 : 2), hx = cc >> 6, n = cc & 63, g = (cc >> 6) & 1;
              LAS unsigned char* T1 = role == 0 ? L + (4 + 2 * hx) * TILE_B : role == 1 ? L + (2 * g + 1) * TILE_B : L + (2 * g) * TILE_B;
              LAS unsigned char* T2 = L + (5 + 2 * (hx & 3)) * TILE_B;
              if (!(role == 2 && !OUT)) {
#pragma unroll 4
              for (int t = 0; t < 64; ++t) { const float x3 = bf2f(src[(size_t)t * NPROJ]); const float y = silu(cb + w0 * x0 + w1 * x1 + w2 * x2 + w3 * x3); x0 = x1; x1 = x2; x2 = x3;
                  *(LAS bf16*)(T1 + toff(t, n)) = (bf16)f2bf(y);
                  if (role == 0) *(LAS bf16*)(T2 + toff(t, n)) = (bf16)f2bf(y * DTW[hx * 64 + t]); } }
            }
        }
        __syncthreads();
        if (BR == 2) dsum += TOT[hd];
        f32x16 OT[2], OI[2];
#pragma unroll
        for (int i = 0; i < 16; ++i) { OT[0][i] = 0.f; OT[1][i] = 0.f; OI[0][i] = 0.f; OI[1][i] = 0.f; }
        if (OUT) {
#pragma unroll
            for (int si = 0; si < 2; ++si) {
                if (si > th) continue;
                f32x16 ST;
#pragma unroll
                for (int i = 0; i < 16; ++i) ST[i] = 0.f;
#pragma unroll
                for (int ks = 0; ks < 4; ++ks) ST = MFMA32(ld128(Kt + toff(32 * si + r, 16 * ks + 8 * hh)), ld128(Qt + toff(32 * th + r, 16 * ks + 8 * hh)), ST);
                if (BR == 2) { const float ct = CUM[hd * 64 + 32 * th + r];
#pragma unroll
                    for (int g4 = 0; g4 < 4; ++g4) { const f32x4 cs = *(LAS f32x4*)(CUM + hd * 64 + 32 * si + 8 * g4 + 4 * hh), ds = *(LAS f32x4*)(DTS + hd * 64 + 32 * si + 8 * g4 + 4 * hh);
#pragma unroll
                        for (int e = 0; e < 4; ++e) { const int i = 4 * g4 + e; const bool keep = (si < th) || (crow(i, hh) <= r); ST[i] = keep ? ST[i] * ex2(ct - cs[e]) * ds[e] : 0.f; } }
                } else if (si == th) {
#pragma unroll
                    for (int i = 0; i < 16; ++i) ST[i] = (crow(i, hh) <= r) ? ST[i] : 0.f;
                }
                __builtin_amdgcn_sched_barrier(0);
                const bf16x8 p0 = packacc<0>(ST), p1 = packacc<1>(ST);
#pragma unroll
                for (int vi = 0; vi < 2; ++vi) { OT[vi] = MFMA32(trfrag<true>(Vt, 32 * si, 32 * vi, lane), p0, OT[vi]); OT[vi] = MFMA32(trfrag<true>(Vt, 32 * si + 16, 32 * vi, lane), p1, OT[vi]); }
            }
        }
        __builtin_amdgcn_sched_barrier(0);
        if (BR != 2) {
#pragma unroll
            for (int ki = 0; ki < 2; ++ki)
#pragma unroll
                for (int g4 = 0; g4 < 4; ++g4) { const f32x4 e4 = *(LAS f32x4*)(ECM + hd * 64 + 32 * ki + 8 * g4 + 4 * hh);
#pragma unroll
                    for (int e = 0; e < 4; ++e) { H[ki][0][4 * g4 + e] *= e4[e]; H[ki][1][4 * g4 + e] *= e4[e]; } }
        }
        __builtin_amdgcn_sched_barrier(0);
        if (OUT) {
#pragma unroll
            for (int ki = 0; ki < 2; ++ki) {
                const bf16x8 q0 = cat8(ld64(Qt + toff(32 * th + r, 32 * ki + 4 * hh)), ld64(Qt + toff(32 * th + r, 32 * ki + 8 + 4 * hh)));
                const bf16x8 q1 = cat8(ld64(Qt + toff(32 * th + r, 32 * ki + 16 + 4 * hh)), ld64(Qt + toff(32 * th + r, 32 * ki + 24 + 4 * hh)));
#pragma unroll
                for (int vj = 0; vj < 2; ++vj) {
                    if (BR == 2) { OI[vj] = MFMA32(packacc<0>(H[ki][vj]), q0, OI[vj]); OI[vj] = MFMA32(packacc<1>(H[ki][vj]), q1, OI[vj]); }
                    else { OT[vj] = MFMA32(packacc<0>(H[ki][vj]), q0, OT[vj]); OT[vj] = MFMA32(packacc<1>(H[ki][vj]), q1, OT[vj]); } }
            }
            if (BR == 2) { const float ect = ex2(CUM[hd * 64 + 32 * th + r]);
#pragma unroll
                for (int i = 0; i < 16; ++i) { OT[0][i] += OI[0][i] * ect; OT[1][i] += OI[1][i] * ect; } }
        }
        __builtin_amdgcn_sched_barrier(0);
        if (BR == 2) { const float et = ex2(TOT[hd]);
#pragma unroll
            for (int i = 0; i < 16; ++i) { H[0][0][i] *= et; H[0][1][i] *= et; H[1][0][i] *= et; H[1][1][i] *= et; } }
#pragma unroll
        for (int s4 = 0; s4 < 4; ++s4) {
            const bf16x8 a0 = trfrag<false>(Kt, 16 * s4, 0, lane), a1 = trfrag<false>(Kt, 16 * s4, 32, lane);
            LAS unsigned char* VV = BR == 2 ? Wt : Vt;
            const bf16x8 b0 = trfrag<false>(VV, 16 * s4, 0, lane), b1 = trfrag<false>(VV, 16 * s4, 32, lane);
            H[0][0] = MFMA32(a0, b0, H[0][0]); H[0][1] = MFMA32(a0, b1, H[0][1]); H[1][0] = MFMA32(a1, b0, H[1][0]); H[1][1] = MFMA32(a1, b1, H[1][1]);
            __builtin_amdgcn_sched_barrier(0);
        }
        if (BR != 2) {
#pragma unroll
            for (int ki = 0; ki < 2; ++ki)
#pragma unroll
                for (int g4 = 0; g4 < 4; ++g4) { const f32x4 e4 = *(LAS f32x4*)(ETL + hd * 64 + 32 * ki + 8 * g4 + 4 * hh);
#pragma unroll
                    for (int e = 0; e < 4; ++e) { H[ki][0][4 * g4 + e] *= e4[e]; H[ki][1][4 * g4 + e] *= e4[e]; } }
        }
        __builtin_amdgcn_sched_barrier(0);
#ifdef X_NOEPI
        if (OUT) { asm volatile("" :: "v"(OT[0]), "v"(OT[1])); }
        if (false) {
#else
        if (OUT) {
#endif
            const size_t rowt = rowc + 32 * th + r;
            float ss = 0.f;
            if (BR == 2) { const float Dh = INP(F, 27)[l * 4 + hd];
#pragma unroll
                for (int vi = 0; vi < 2; ++vi)
#pragma unroll
                    for (int g4 = 0; g4 < 4; ++g4) { const int v0 = 32 * vi + 8 * g4 + 4 * hh;
                        const v2u xz = *(LAS v2u*)(Vt + toff(32 * th + r, v0)); const v2u zz = *(const v2u*)(PJ + rowt * NPROJ + 2560 + hd * 64 + v0);
#pragma unroll
                        for (int e = 0; e < 4; ++e) { const unsigned xw = xz[e >> 1], zw = zz[e >> 1]; const float x = (e & 1) ? __uint_as_float(xw & 0xffff0000u) : __uint_as_float(xw << 16), z = (e & 1) ? __uint_as_float(zw & 0xffff0000u) : __uint_as_float(zw << 16);
                            const float my = (OT[vi][4 * g4 + e] + Dh * x) * silu(z); OT[vi][4 * g4 + e] = my; ss += my * my; } }
                ss += __shfl_xor(ss, 32);
                if (hh == 0) SSQ[hd * 64 + 32 * th + r] = ss;
                __syncthreads();
                ss = (SSQ[32 * th + r] + SSQ[64 + 32 * th + r]) + (SSQ[128 + 32 * th + r] + SSQ[192 + 32 * th + r]);
            } else {
#pragma unroll
                for (int i = 0; i < 16; ++i) ss += OT[0][i] * OT[0][i] + OT[1][i] * OT[1][i];
                ss += __shfl_xor(ss, 32);
            }
            const float rs = 1.f / sqrtf(ss * (BR == 2 ? 1.f / 256.f : 1.f / 64.f) + EPS);
            const float* nw = INP(F, BR == 0 ? 10 : BR == 1 ? 12 : 28) + l * 256 + hd * 64;
            LAS unsigned char* STG = BR == 2 ? Vt : Qt;
#pragma unroll
            for (int vi = 0; vi < 2; ++vi)
#pragma unroll
                for (int g4 = 0; g4 < 4; ++g4) { const int v0 = 32 * vi + 8 * g4 + 4 * hh; const f32x4 w4 = *(const f32x4*)(nw + v0);
                    float o[4];
                    if (BR == 2) {
#pragma unroll
                        for (int e = 0; e < 4; ++e) o[e] = OT[vi][4 * g4 + e] * rs * w4[e];
                    } else { const v2u gz = *(const v2u*)(PJ + rowt * NPROJ + (BR == 0 ? 768 : 1792) + hd * 64 + v0);
#pragma unroll
                        for (int e = 0; e < 4; ++e) { const unsigned gw = gz[e >> 1]; const float g = (e & 1) ? __uint_as_float(gw & 0xffff0000u) : __uint_as_float(gw << 16); o[e] = OT[vi][4 * g4 + e] * rs * w4[e] * silu(g); } }
                    v2u pk; pk.x = cvtpk(o[0], o[1]); pk.y = cvtpk(o[2], o[3]);
                    *(LAS v2u*)(STG + toff(32 * th + r, v0)) = pk; __builtin_amdgcn_sched_barrier(0); }
            LDS_WAIT();
#pragma unroll
            for (int it = 0; it < 4; ++it) { const int rw = it * 8 + (lane >> 3), pc = lane & 7;
                const v4u v = *(LAS v4u*)(STG + toff(32 * th + rw, 8 * pc));
                *(v4u*)(MX + (rowc + 32 * th + rw) * DM + (BR == 0 ? 0 : BR == 1 ? 256 : 768) + hd * 64 + 8 * pc) = v; }
        }
        __syncthreads();
    }
    if (!OUT) {
        const size_t u = (size_t)(pm * 12 + hid);
        if (th == 0) {
#pragma unroll
            for (int ki = 0; ki < 2; ++ki)
#pragma unroll
                for (int vj = 0; vj < 2; ++vj)
#pragma unroll
                    for (int i = 0; i < 16; ++i) SLOC[(u * 64 + 32 * ki + crow(i, hh)) * 64 + 32 * vj + r] = H[ki][vj][i];
        }
        if (BR == 1) { LAS float* XC = ECM;
            if (th == 1) XC[hd * 64 + lane] = dsum;
            __syncthreads();
            if (th == 0) DTOT[u * 64 + lane] = dsum + XC[hd * 64 + lane];
        } else if (th == 0) DTOT[u * 64 + lane] = dsum;
    } else if (sc == 7) {
        float* ho = OUTP(F) + (BR == 0 ? O_PRET : BR == 1 ? O_PHGRN : O_PM2) + (size_t)((l * NB + b) * 4 + hd) * 4096;
        if (th == 0) {
#pragma unroll
            for (int ki = 0; ki < 2; ++ki)
#pragma unroll
                for (int vj = 0; vj < 2; ++vj)
#pragma unroll
                    for (int i = 0; i < 16; ++i) ho[(32 * ki + crow(i, hh)) * 64 + 32 * vj + r] = H[ki][vj][i];
        }
        if (BR == 2) { float* cbo = OUTP(F) + O_PCONV + (size_t)(l * NB + b) * 1536;
            for (int e = tid; e < 1536; e += NTHR) { const int i = e / 512, cc = e % 512; cbo[e] = bf2f(PJ[(row0 + 253 + i) * NPROJ + 2816 + cc]); } }
    }
}

typedef float f32x4v __attribute__((ext_vector_type(4)));
#define MFMA16(a, b, c) __builtin_amdgcn_mfma_f32_16x16x32_bf16((a), (b), (c), 0, 0, 0)
constexpr int S5_IMG = 0, S5_GY = 65536, S5_GYP = 528;
template <bool OUT> DI void s5_mfma_unit(Frame& F, int l, int pm) {
    LAS unsigned char* L = F.lds; unsigned char* ws = WSP(F);
    int tid_ = F.tid; asm volatile("" : "+v"(tid_));
    const int tid = tid_, lane = tid & 63, wv = __builtin_amdgcn_readfirstlane(tid >> 6), r = lane & 31, hh = lane >> 5;
    const int b = pm >> 3, sc = pm & 7; const size_t row0 = (size_t)pm * 256;
    const bf16* PJ = (const bf16*)(ws + WS_PROJ); bf16* MX = (bf16*)(ws + WS_MIXED);
    const float* AB = (const float*)(ws + WS_S5AB); const float* APOW = (const float*)(ws + WS_S5APOW); const float* A256 = (const float*)(ws + WS_S5A256);
    const bf16* BBH = (const bf16*)(ws + WS_S5BBH); const bf16* CXH = (const bf16*)(ws + WS_S5CXH); float* ELOC = (float*)(ws + WS_S5LOC);
    LAS unsigned char* IMR = L + S5_IMG + wv * 8192; LAS unsigned char* IMI = IMR + 4096;
    LAS unsigned char* GYT = L + S5_GY;
    const int trow = 16 * ((r >> 2) & 1) + (r & 3) + 4 * (r >> 3);
    float cr[2][2], ci[2][2];
#pragma unroll
    for (int gg = 0; gg < 2; ++gg)
#pragma unroll
        for (int ph = 0; ph < 2; ++ph) { cr[gg][ph] = 0.f; ci[gg][ph] = 0.f; }
    if (OUT) {
        for (int j = 0; j < sc; ++j)
#pragma unroll
            for (int gg = 0; gg < 2; ++gg)
#pragma unroll
                for (int ph = 0; ph < 2; ++ph) { const int g = 2 * wv + gg, p = 32 * ph + r; const size_t ix = (size_t)((l * 16 + g) * 64 + p) * 2;
                    const float ar = A256[ix], ai = A256[ix + 1]; const float* e = ELOC + (size_t)(((pm - sc + j) * 16 + g) * 64 + p) * 2;
                    const float nr = ar * cr[gg][ph] - ai * ci[gg][ph] + e[0], ni = ar * ci[gg][ph] + ai * cr[gg][ph] + e[1]; cr[gg][ph] = nr; ci[gg][ph] = ni; }
    }
#pragma unroll 1
    for (int c4 = 0; c4 < 4; ++c4) {
        const size_t rowc = row0 + 64 * c4;
#pragma unroll 1
        for (int gg = 0; gg < 2; ++gg) {
            const int g = 2 * wv + gg;
            float cr0 = gg == 0 ? cr[0][0] : cr[1][0], ci0 = gg == 0 ? ci[0][0] : ci[1][0], cr1 = gg == 0 ? cr[0][1] : cr[1][1], ci1 = gg == 0 ? ci[0][1] : ci[1][1];
            bf16x8 bbf[2][2]; bf16x8 cxf[4];
#pragma unroll
            for (int ph = 0; ph < 2; ++ph)
#pragma unroll
                for (int ri = 0; ri < 2; ++ri) bbf[ph][ri] = *(const bf16x8*)(BBH + ((size_t)(((l * 16 + g) * 2 + ri) * 64 + 32 * ph + r)) * 16 + 8 * hh);
            if (OUT) {
#pragma unroll
                for (int ks = 0; ks < 4; ++ks) cxf[ks] = *(const bf16x8*)(CXH + ((size_t)((l * 16 + g) * 16 + (lane & 15))) * 128 + 32 * ks + 8 * (lane >> 4));
            }
#pragma unroll 1
            for (int tl = 0; tl < 2; ++tl) {
                const bf16x8 ua = *(const bf16x8*)(PJ + (rowc + 32 * tl + trow) * NPROJ + 2048 + g * 16 + 8 * hh);
#pragma unroll
                for (int ph = 0; ph < 2; ++ph) {
                    const size_t ix = (size_t)((l * 16 + g) * 64 + 32 * ph + r);
                    const float ar = AB[2 * ix], ai = AB[2 * ix + 1];
                    f32x16 zr;
#pragma unroll
                    for (int i = 0; i < 16; ++i) zr[i] = 0.f;
                    f32x16 bre = MFMA32(ua, bbf[ph][0], zr), bim = MFMA32(ua, bbf[ph][1], zr);
                    float hr = ph == 0 ? cr0 : cr1, hi_ = ph == 0 ? ci0 : ci1;
                    if (!OUT) { hr = 0.f; hi_ = 0.f; } else if (hh) { hr = 0.f; hi_ = 0.f; }
#pragma unroll
                    for (int i = 0; i < 16; ++i) { const float nr = ar * hr - ai * hi_ + bre[i], ni = ar * hi_ + ai * hr + bim[i]; hr = nr; hi_ = ni; bre[i] = nr; bim[i] = ni; }
                    const float pr = __shfl_xor(hr, 32), pi = __shfl_xor(hi_, 32);
                    if (OUT) {
                        const float c1r = hh ? pr : 0.f, c1i = hh ? pi : 0.f;
                        const f32x4v* ap = (const f32x4v*)(APOW + ix * 32);
#pragma unroll
                        for (int i2 = 0; i2 < 8; ++i2) { const f32x4v a4 = ap[i2];
                            bre[2 * i2] += a4[0] * c1r - a4[1] * c1i; bim[2 * i2] += a4[0] * c1i + a4[1] * c1r;
                            bre[2 * i2 + 1] += a4[2] * c1r - a4[3] * c1i; bim[2 * i2 + 1] += a4[2] * c1i + a4[3] * c1r; }
                        const float fr_ = bre[15], fi_ = bim[15]; const float qr = __shfl_xor(fr_, 32), qi = __shfl_xor(fi_, 32);
                        const float ncr = hh ? fr_ : qr, nci = hh ? fi_ : qi;
                        if (ph == 0) { cr0 = ncr; ci0 = nci; } else { cr1 = ncr; ci1 = nci; }
#pragma unroll
                        for (int g4 = 0; g4 < 4; ++g4) { v2u pr2, pi2; pr2.x = cvtpk(bre[4 * g4], bre[4 * g4 + 1]); pr2.y = cvtpk(bre[4 * g4 + 2], bre[4 * g4 + 3]); pi2.x = cvtpk(bim[4 * g4], bim[4 * g4 + 1]); pi2.y = cvtpk(bim[4 * g4 + 2], bim[4 * g4 + 3]);
                            *(LAS v2u*)(IMR + (32 * ph + r) * 64 + (16 * hh + 4 * g4) * 2) = pr2; *(LAS v2u*)(IMI + (32 * ph + r) * 64 + (16 * hh + 4 * g4) * 2) = pi2; }
                    } else {
                        const float e0r = hh ? pr : hr, e0i = hh ? pi : hi_, e1r = hh ? hr : pr, e1i = hh ? hi_ : pi;
                        const float a16r = APOW[ix * 32 + 30], a16i = APOW[ix * 32 + 31]; const float a32r = a16r * a16r - a16i * a16i, a32i = 2.f * a16r * a16i;
                        float& ccr = ph == 0 ? cr0 : cr1; float& cci = ph == 0 ? ci0 : ci1;
                        const float nr = a32r * ccr - a32i * cci + (a16r * e0r - a16i * e0i) + e1r, ni = a32r * cci + a32i * ccr + (a16r * e0i + a16i * e0r) + e1i; ccr = nr; cci = ni;
                    }
                }
                if (OUT) {
                    LDS_WAIT();
                    const int gi = lane >> 4, q = (lane & 15) >> 2, pp = lane & 3;
#pragma unroll
                    for (int tt = 0; tt < 2; ++tt) {
                        f32x4v y = {0.f, 0.f, 0.f, 0.f};
#pragma unroll
                        for (int ks = 0; ks < 4; ++ks) { LAS unsigned char* im = (ks < 2 ? IMR : IMI) + (32 * (ks & 1) + 8 * gi + q) * 64 + (16 * tt + 4 * pp) * 2;
                            y = MFMA16(cxf[ks], cat8(ldtr(im), ldtr(im + 4 * 64)), y); }
                        const int t = 32 * tl + 16 * tt + (lane & 15);
                        const v2u u4 = *(const v2u*)(PJ + (rowc + t) * NPROJ + 2048 + g * 16 + 4 * gi); const f32x4v d4 = *(const f32x4v*)(INP(F, 20) + l * 256 + g * 16 + 4 * gi);
                        float o[4];
#pragma unroll
                        for (int e = 0; e < 4; ++e) { const unsigned uw = u4[e >> 1]; const float u = (e & 1) ? __uint_as_float(uw & 0xffff0000u) : __uint_as_float(uw << 16); o[e] = gelu_tanh(y[e] + d4[e] * u); }
                        v2u pk; pk.x = cvtpk(o[0], o[1]); pk.y = cvtpk(o[2], o[3]);
                        *(LAS v2u*)(GYT + t * S5_GYP + (g * 16 + 4 * gi) * 2) = pk; }
                    LDS_WAIT();
                }
            }
            if (gg == 0) { cr[0][0] = cr0; ci[0][0] = ci0; cr[0][1] = cr1; ci[0][1] = ci1; } else { cr[1][0] = cr0; ci[1][0] = ci0; cr[1][1] = cr1; ci[1][1] = ci1; }
        }
        if (OUT) {
            __syncthreads();
            const bf16* WG = (const bf16*)(ws + WS_WGLUT) + (size_t)l * 65536; LAS unsigned char* STG = IMR;
#pragma unroll 1
            for (int t2 = 0; t2 < 2; ++t2) {
                f32x16 Z;
#pragma unroll
                for (int i = 0; i < 16; ++i) Z[i] = 0.f;
#pragma unroll 4
                for (int ks = 0; ks < 16; ++ks) Z = MFMA32(*(const bf16x8*)(WG + (size_t)(32 * wv + r) * 256 + 16 * ks + 8 * hh), ld128(GYT + (32 * t2 + r) * S5_GYP + (16 * ks + 8 * hh) * 2), Z);
                const int t = 32 * t2 + r;
#pragma unroll
                for (int g4 = 0; g4 < 4; ++g4) { const int n0 = 32 * wv + 8 * g4 + 4 * hh;
                    const v2u gy2 = *(LAS v2u*)(GYT + t * S5_GYP + n0 * 2); const v2u sg2 = *(const v2u*)(PJ + (rowc + t) * NPROJ + 2304 + n0); const f32x4v b4 = *(const f32x4v*)(INP(F, 22) + l * 256 + n0);
                    float o[4];
#pragma unroll
                    for (int e = 0; e < 4; ++e) { const unsigned gw = gy2[e >> 1], sw = sg2[e >> 1]; const float gy = (e & 1) ? __uint_as_float(gw & 0xffff0000u) : __uint_as_float(gw << 16), sg = (e & 1) ? __uint_as_float(sw & 0xffff0000u) : __uint_as_float(sw << 16);
                        o[e] = gy * sigm(Z[4 * g4 + e] + b4[e]) * silu(sg); }
                    v2u pk; pk.x = cvtpk(o[0], o[1]); pk.y = cvtpk(o[2], o[3]);
                    *(LAS v2u*)(STG + t * 80 + (8 * g4 + 4 * hh) * 2) = pk; }
            }
            LDS_WAIT();
#pragma unroll
            for (int it = 0; it < 4; ++it) { const int rw = it * 16 + (lane >> 2), pc = lane & 3;
                const v4u v = *(LAS v4u*)(STG + rw * 80 + pc * 16);
                *(v4u*)(MX + (rowc + rw) * DM + 512 + 32 * wv + 8 * pc) = v; }
            __syncthreads();
        }
    }
    if (!OUT) {
        if (hh == 0) {
#pragma unroll
            for (int gg = 0; gg < 2; ++gg)
#pragma unroll
                for (int ph = 0; ph < 2; ++ph) { float* e = ELOC + (size_t)((pm * 16 + 2 * wv + gg) * 64 + 32 * ph + r) * 2; e[0] = cr[gg][ph]; e[1] = ci[gg][ph]; }
        }
    } else if (sc == 7 && hh == 0) {
        float* out = OUTP(F);
#pragma unroll
        for (int gg = 0; gg < 2; ++gg)
#pragma unroll
            for (int ph = 0; ph < 2; ++ph) { const size_t o = (size_t)((l * NB + b) * 16 + 2 * wv + gg) * 64 + 32 * ph + r; out[O_PS5R + o] = cr[gg][ph]; out[O_PS5I + o] = ci[gg][ph]; }
    }
}
DI void mixers_m1(Frame& F, int l) {
    for (int u = F.bx; u < 256; u += F.G) { const int pm = u >> 2, br = u & 3;
        if (br == 0) lin_unit<0, false>(F, l, pm); else if (br == 1) lin_unit<1, false>(F, l, pm); else if (br == 2) lin_unit<2, false>(F, l, pm); else s5_mfma_unit<false>(F, l, pm); }
}
DI void mixers_m3(Frame& F, int l) {
    float* out = OUTP(F);
    constexpr int U_LR = 256, U_SLR = 1536, U_SS5 = 2048, U_ALL = U_LR + U_SLR + U_SS5;
    for (int u = F.bx; u < U_ALL; u += F.G) {
        int r = u;
        if (r < U_LR) { const int pm = r >> 2, br = r & 3;
            if (br == 0) lin_unit<0, true>(F, l, pm); else if (br == 1) lin_unit<1, true>(F, l, pm); else if (br == 2) lin_unit<2, true>(F, l, pm); else s5_mfma_unit<true>(F, l, pm);
            continue; } r -= U_LR;
        if (r < U_SLR) { const int s = r / 12, hid = r % 12, br = hid >> 2, h = hid & 3;
            const size_t so = (size_t)((l * MSAMP + s) * 4 + h) * 4096;
            const float* hi = INP(F, br == 0 ? 2 : br == 1 ? 3 : 6) + so; float* ho = out + (br == 0 ? O_SRET : br == 1 ? O_SHGRN : O_SM2) + so;
            linrec_unit(F, l, br, h, MPROMPT + s, 1, 2048, hi, ho, INP(F, 7) + (size_t)(l * MSAMP + s) * 1536, out + O_SCONV + (size_t)(l * MSAMP + s) * 1536); continue; } r -= U_SLR;
        { const int s = r >> 4, g = r & 15; const size_t so = (size_t)((l * MSAMP + s) * 16 + g) * 64;
            s5_unit(F, l, g, MPROMPT + s, 1, INP(F, 4) + so, INP(F, 5) + so, out + O_SS5R + so, out + O_SS5I + so); }
    }
}
DI void fixups(Frame& F, int l) {
    unsigned char* ws = WSP(F);
    bf16* MX = (bf16*)(ws + WS_MIXED); const float* MSQ = (const float*)(ws + WS_MSQ); const float* nw = INP(F, 28) + l * 256;
    const bf16* GY = (const bf16*)(ws + WS_GY); const bf16* ZB = (const bf16*)(ws + WS_ZB); const bf16* PJ = (const bf16*)(ws + WS_PROJ);
    const int gw = F.vcu * NWAVES + F.wave, NGW = F.G * NWAVES, lane = F.lane;
    const f32x4 w4 = *((const f32x4*)nw + lane);
    for (int m = MPROMPT + gw; m < MVALID; m += NGW) {
        const f32x4 q = *(const f32x4*)(MSQ + (size_t)m * 4); const float sc = 1.f / sqrtf(((q.x + q.y) + (q.z + q.w)) * (1.f / 256.f) + EPS);
        if (m >= MPROMPT) {
        v2u* p = (v2u*)(MX + (size_t)m * DM + 768) + lane; const v2u x = *p;
        v2u o; o.x = pk2(__uint_as_float(x.x << 16) * sc * w4.x, __uint_as_float(x.x & 0xffff0000u) * sc * w4.y); o.y = pk2(__uint_as_float(x.y << 16) * sc * w4.z, __uint_as_float(x.y & 0xffff0000u) * sc * w4.w);
        *p = o; }
        const v2u g = *((const v2u*)(GY + (size_t)m * 256) + lane), z = *((const v2u*)(ZB + (size_t)m * 256) + lane), sg = *((const v2u*)(PJ + (size_t)m * NPROJ + 2304) + lane);
        float r[4];
#pragma unroll
        for (int i = 0; i < 2; ++i) {
            r[2 * i] = __uint_as_float(g[i] << 16) * sigm(__uint_as_float(z[i] << 16)) * silu(__uint_as_float(sg[i] << 16));
            r[2 * i + 1] = __uint_as_float(g[i] & 0xffff0000u) * sigm(__uint_as_float(z[i] & 0xffff0000u)) * silu(__uint_as_float(sg[i] & 0xffff0000u)); }
        v2u o2; o2.x = pk2(r[0], r[1]); o2.y = pk2(r[2], r[3]);
        *((v2u*)(MX + (size_t)m * DM + 512) + lane) = o2;
    }
}
__global__ void __launch_bounds__(NTHR, 2) mk_fwd(Args args) {
    extern __shared__ __attribute__((aligned(16))) unsigned char lds[];
    Frame F;
    F.lds = (LAS unsigned char*)lds; F.MISC = (volatile LAS unsigned*)(F.lds + MISC_OFF);
    const int wave0 = __builtin_amdgcn_readfirstlane(threadIdx.x >> 6);
    F.tid = threadIdx.x; F.lane = F.tid & 63; F.wave = wave0;
    F.G = gridDim.x; { const int bx = blockIdx.x; F.vcu = (F.G % 8 == 0) ? (bx % 8) * (F.G / 8) + bx / 8 : bx; }
    F.ka = (const float* const*)__builtin_amdgcn_kernarg_segment_ptr(); F.out_ = args.out; F.ws_ = args.ws; F.ctl = (gu32*)(args.ws + WS_CTL);
    for (int u = F.tid; u < (LDS_BYTES - LDSCTL_OFF) / 4; u += NTHR) ((LAS unsigned*)(F.lds + LDSCTL_OFF))[u] = 0u;
    __syncthreads();
    XcdBarrier bar; bar.bar = (unsigned*)(F.ctl + CW_BAR); bar.x = 0; bar.st = nullptr;
    if (MK_N_LAUNCHES == 1) bar = xcd_barrier_post((unsigned*)(F.ctl + CW_BAR), F.MISC + 8);
    const int lo = args.ph_lo, hi = args.ph_hi;
#pragma unroll 1
    for (int ph = lo; ph < hi; ++ph) {
        int tid; asm volatile("v_mbcnt_lo_u32_b32 %0, -1, 0\n\tv_mbcnt_hi_u32_b32 %0, -1, %0" : "=v"(tid)); tid += wave0 * 64;
        F.tid = tid; F.lane = tid & 63; F.wave = __builtin_amdgcn_readfirstlane(tid >> 6);
        { int bx = blockIdx.x, G = gridDim.x; asm volatile("" : "+s"(bx), "+s"(G)); F.bx = bx; F.G = G; F.vcu = (G % 8 == 0) ? (bx % 8) * (G / 8) + bx / 8 : bx; }
        const int l = ph >= 8 ? 1 : 0, sub = ph == 0 ? -1 : ph - 1 - 7 * l;
        if (ph == 0) { prologue(F); }
        else if (sub == 0) {
            unsigned char* ws = WSP(F); bf16* XB = (bf16*)(ws + WS_XB); bf16* PROJ = (bf16*)(ws + WS_PROJ);
            pg8::Gemm g{XB, (const bf16*)(ws + WS_WINT) + (size_t)l * NPROJ * DM, MPAD, NPROJ, DM}; pg8::StaticOrder S; S.init(MPAD, NPROJ, F.G, F.bx);
            pg8::EpiBf16<0> E{PROJ, NPROJ, nullptr, 0, 0, 1.f};
#ifndef X_NOGEMM
            pg8::gemm_phase<pg8::EpiBf16<0>, pg8::StaticOrder, true, true>(F.lds + RING_OFF, g, S, E, tid);
#endif
        } else if (sub == 1) { mixers_m1(F, l); }
        else if (sub == 2) { mixers_m3(F, l); }
        else if (sub == 3) {
            unsigned char* ws = WSP(F); bf16* GY = (bf16*)(ws + WS_GY);
            pg8::Gemm g{GY + (size_t)MPROMPT * 256, (const bf16*)(ws + WS_WGLUT) + (size_t)l * 65536, 256, 256, 256}; pg8::StaticOrder S; S.init(256, 256, F.G, F.bx);
            pg8::EpiBf16<0> E{(bf16*)(ws + WS_ZB) + (size_t)MPROMPT * 256, 256, INP(F, 22) + l * 256, 0, 0, 1.f};
#ifndef X_NOGEMM
            pg8::gemm_phase<pg8::EpiBf16<0>, pg8::StaticOrder, true, true>(F.lds + RING_OFF, g, S, E, tid);
#endif
        } else if (sub == 4) { fixups(F, l); }
        else if (sub == 5) {
            unsigned char* ws = WSP(F); bf16* MX = (bf16*)(ws + WS_MIXED);
            pg8::Gemm g{MX, (const bf16*)(ws + WS_WOUTT) + (size_t)l * DM * DM, MPAD, DM, DM}; pg8::StaticOrder S; S.init(MPAD, DM, F.G, F.bx);
            pg8::EpiResid E{INP(F, 0), INP(F, 1), OUTP(F), l == 0 ? 1 : 0};
#ifndef X_NOGEMM
            pg8::gemm_phase<pg8::EpiResid, pg8::StaticOrder, true, true>(F.lds + RING_OFF, g, S, E, tid);
#endif
        } else { if (l == 0) aprep(F, 1); else final_norm(F); }
        if (ph + 1 < hi) xcd_barrier(bar);
    }
}

extern "C" void kernel_launch(void* const* d_in, const int* in_sizes, int n_in, void* d_out, int out_size, void* d_ws, size_t ws_size, hipStream_t stream) {
    static int grid = 0;
    if (grid == 0) {
        if (n_in != 31 || out_size != (int)O_TOTAL || ws_size < WS_END) { fprintf(stderr, "kernel_launch: unexpected shapes: n_in %d out %d ws %zu\n", n_in, out_size, ws_size); grid = -1; return; }
        int dev = 0, cus = 0, per_cu = 0;
        if (hipGetDevice(&dev) != hipSuccess || hipDeviceGetAttribute(&cus, hipDeviceAttributeMultiprocessorCount, dev) != hipSuccess) { grid = -1; return; }
        if (hipFuncSetAttribute((const void*)mk_fwd, hipFuncAttributeMaxDynamicSharedMemorySize, LDS_BYTES) != hipSuccess) { fprintf(stderr, "kernel_launch: hipFuncSetAttribute failed\n"); grid = -1; return; }
        if (hipOccupancyMaxActiveBlocksPerMultiprocessor(&per_cu, (const void*)mk_fwd, NTHR, LDS_BYTES) != hipSuccess || per_cu < 1) { fprintf(stderr, "kernel_launch: occupancy query says %d\n", per_cu); per_cu = 1; }
        (void)hipGetLastError();
        grid = cus;
    }
    if (grid < 0) return;
    (void)hipMemsetAsync((char*)d_ws + WS_CTL, 0, CTL_ZERO_BYTES, stream);
    Args a{};
    for (int i = 0; i < 31; ++i) a.in[i] = (const float*)d_in[i];
    a.out = (float*)d_out; a.ws = (unsigned char*)d_ws;
    if (MK_N_LAUNCHES == 1) { a.ph_lo = 0; a.ph_hi = N_PHASES; a.li = 0; hipLaunchKernelGGL(mk_fwd, dim3(grid), dim3(NTHR), LDS_BYTES, stream, a); }
    else for (int p = 0; p < N_PHASES; ++p) { a.ph_lo = p; a.ph_hi = p + 1; a.li = p; hipLaunchKernelGGL(mk_fwd, dim3(grid), dim3(NTHR), LDS_BYTES, stream, a); }
}
```

```cpp
#include <hip/hip_runtime.h>
#include <cstdio>
#include <cstdint>
namespace pg8 {
#define PG8_LAS __attribute__((address_space(3)))
typedef unsigned short bf16_t;
typedef short bf16x8 __attribute__((ext_vector_type(8)));
typedef float f32x4 __attribute__((ext_vector_type(4)));
typedef unsigned u32x4 __attribute__((ext_vector_type(4)));
constexpr int BM = 256, BK = 64, HALF = 128, HTB = HALF * BK * 2  , STAGE_BYTES = 8 * HTB, NXCD = 8, WGM = 8;

__host__ __device__ __forceinline__ int lds_byte(int r, int c) { const int st = (r >> 4) * 2 + (c >> 5), rr = r & 15, cc = c & 31, ob = rr * 64 + cc * 2; return st * 1024 + (ob ^ (((ob >> 9) & 1) << 5)); }
__host__ __device__ __forceinline__ void stage_rc(int b, int& R, int& C) { const int st = b / 1024, sb = b % 1024, swz = sb ^ (((sb >> 9) & 1) << 5); R = (st >> 1) * 16 + swz / 64; C = (st & 1) * 32 + (swz % 64) / 2; }
__host__ __device__ __forceinline__ int perm32(int rho) { const int n = rho >> 4, i = rho & 15; return 8 * (i >> 2) + 4 * n + (i & 3); }

struct Unit { int pm, pn; };
struct Gemm { const bf16_t* A; const bf16_t* Bt; int M, N, K; };

struct StaticOrder {
    int nM, nN, nwg, G, c;
    __host__ __device__ void init(int M, int N, int G_, int c_) { nM = M / BM; nN = N / BM; nwg = nM * nN; G = G_; c = c_; }
    __host__ __device__ bool next(int i, Unit& u) const {
        const long L = (long)i * G + c; if (L >= nwg) return false;
        int wgid = (int)L; { const int q = nwg / NXCD, r = nwg % NXCD, xcd = wgid % NXCD, off = wgid / NXCD; wgid = (xcd < r ? xcd * (q + 1) : r * (q + 1) + (xcd - r) * q) + off; }
        const int nig = WGM * nN, gid = wgid / nig, fm = gid * WGM, gsz = (nM - fm) < WGM ? (nM - fm) : WGM;
        u.pm = fm + ((wgid % nig) % gsz); u.pn = (wgid % nig) / gsz; return true;
    }
    __device__ __forceinline__ void a_ready(const Unit&) const {}
    __device__ __forceinline__ void done(const Unit&) const {}
};

__device__ __forceinline__ unsigned cvt_pk_bf16(float lo, float hi) { unsigned r; asm volatile("v_cvt_pk_bf16_f32 %0, %1, %2" : "=v"(r) : "v"(lo), "v"(hi)); return r; }
typedef float f32x2 __attribute__((ext_vector_type(2)));
__device__ __forceinline__ f32x2 gelu_pk(f32x2 v) {
    const f32x2 av = __builtin_elementwise_abs(v), d = av * 0.2316418882f + 1.0f;
    f32x2 t; t.x = __builtin_amdgcn_rcpf(d.x); t.y = __builtin_amdgcn_rcpf(d.y);
    f32x2 q = t * 0.5307027145f + (-0.7265760135f); q = q * t + 0.7107068705f; q = q * t + (-0.142248368f); q = q * t + 0.127414796f; q = q * t;
    const f32x2 s = (v * v) * (-0.72134752044f);
    f32x2 e; e.x = __builtin_amdgcn_exp2f(s.x); e.y = __builtin_amdgcn_exp2f(s.y);
    const f32x2 m = v * (q * e), r = v - m;
    f32x2 o; o.x = v.x < 0.f ? m.x : r.x; o.y = v.y < 0.f ? m.y : r.y; return o;
}

template <int ACT  > struct EpiBf16 {
    static constexpr bool PERM = true, AFTER_DRAIN = false; static_assert(ACT == 0 || ACT == 1, "EpiBf16: ACT is 0 (none) or 1 (gelu_pk)");
    bf16_t* O; int ldc; const float* bias; int split_cols; size_t split_stride; float scale0;
    __device__ __forceinline__ void operator()(const f32x4 (&acc)[2][2][4][2], const Unit& u, int wr, int wc, int fr, int fq) const {
        const int row0 = u.pm * BM + wr * 64 + fr; int colt = u.pn * BM; bf16_t* base = O;
        float sc = 1.f; if (split_cols) { const int t = colt / split_cols; base += (size_t)t * split_stride; colt -= t * split_cols; if (t == 0) sc = scale0; }
        const int col0 = colt + wc * 32 + 8 * fq, bcol0 = u.pn * BM + wc * 32 + 8 * fq;
        f32x4 bv[2][2];
#pragma unroll
        for (int bj = 0; bj < 2; ++bj)
#pragma unroll
            for (int n = 0; n < 2; ++n) bv[bj][n] = bias ? *(const f32x4*)(bias + bcol0 + bj * HALF + 4 * n) : (f32x4){0.f, 0.f, 0.f, 0.f};
#pragma unroll
        for (int ai = 0; ai < 2; ++ai)
#pragma unroll
            for (int m = 0; m < 4; ++m) { bf16_t* rowp = base + (size_t)(row0 + ai * HALF + m * 16) * ldc + col0;
#pragma unroll
                for (int bj = 0; bj < 2; ++bj) { f32x4 v0 = acc[ai][bj][m][0] + bv[bj][0], v1 = acc[ai][bj][m][1] + bv[bj][1];
                    if (ACT == 1) { f32x2 a = gelu_pk((f32x2){v0[0], v0[1]}), b = gelu_pk((f32x2){v0[2], v0[3]}), c = gelu_pk((f32x2){v1[0], v1[1]}), d = gelu_pk((f32x2){v1[2], v1[3]});
                        v0 = (f32x4){a.x, a.y, b.x, b.y}; v1 = (f32x4){c.x, c.y, d.x, d.y}; }
                    v0 = v0 * sc; v1 = v1 * sc; u32x4 w; w.x = cvt_pk_bf16(v0[0], v0[1]); w.y = cvt_pk_bf16(v0[2], v0[3]); w.z = cvt_pk_bf16(v1[0], v1[1]); w.w = cvt_pk_bf16(v1[2], v1[3]);
                    *(u32x4*)(rowp + bj * HALF) = w; } }
    }
};

__device__ __forceinline__ float bf2f(unsigned short b) { return __uint_as_float((unsigned)b << 16); }
__device__ __forceinline__ float ex2(float x) { return __builtin_amdgcn_exp2f(x); }
__device__ __forceinline__ float fexp(float x) { return __builtin_amdgcn_exp2f(x * 1.4426950408889634f); }
__device__ __forceinline__ float sigm(float x) { return 1.f / (1.f + fexp(-x)); }
__device__ __forceinline__ float silu(float x) { return x / (1.f + fexp(-x)); }
struct EpiResid {
    static constexpr bool PERM = false, AFTER_DRAIN = false;
    const float* xp; const float* xs; float* out; int layer0;
    __device__ __forceinline__ void operator()(const f32x4 (&acc)[2][2][4][2], const Unit& u, int wr, int wc, int fr, int fq) const {
        const int row0 = u.pm * BM + wr * 64 + fr, col0 = u.pn * BM + wc * 32 + 4 * fq;
#pragma unroll
        for (int ai = 0; ai < 2; ++ai)
#pragma unroll
            for (int m = 0; m < 4; ++m) { const int row = row0 + ai * HALF + m * 16;
                if (row < 16512) {
                    const float* src = layer0 ? (row < 16384 ? xp + (size_t)row * 1024 : xs + (size_t)(row - 16384) * 1024) : out + (size_t)row * 1024;
                    float* dst = out + (size_t)row * 1024;
#pragma unroll
                    for (int bj = 0; bj < 2; ++bj)
#pragma unroll
                        for (int n = 0; n < 2; ++n) { const int c = col0 + bj * HALF + n * 16; *(f32x4*)(dst + c) = *(const f32x4*)(src + c) + acc[ai][bj][m][n]; }
                }
                asm volatile("" ::: "memory"); }
    }
};
struct EpiGlu {
    static constexpr bool PERM = true, AFTER_DRAIN = false;
    const bf16_t* GY; const bf16_t* PROJ; bf16_t* MIXED; const float* bias;
    __device__ __forceinline__ void operator()(const f32x4 (&acc)[2][2][4][2], const Unit& u, int wr, int wc, int fr, int fq) const {
        const unsigned row0 = u.pm * BM + wr * 64 + fr, col0 = wc * 32 + 8 * fq;
        const char* gyb = (const char*)GY; const char* pjb = (const char*)PROJ; char* mxb = (char*)MIXED;
#pragma unroll
        for (int bj = 0; bj < 2; ++bj) { const unsigned c = col0 + bj * HALF;
            const f32x4 b0 = *(const f32x4*)(bias + c), b1 = *(const f32x4*)(bias + c + 4);
#pragma unroll
            for (int ai = 0; ai < 2; ++ai)
#pragma unroll
                for (int m = 0; m < 4; ++m) { const unsigned row = row0 + ai * HALF + m * 16;
                    const f32x4 z0 = acc[ai][bj][m][0] + b0, z1 = acc[ai][bj][m][1] + b1;
                    const u32x4 g = *(const u32x4*)(gyb + (row * 256u + c) * 2u), s = *(const u32x4*)(pjb + (row * 3328u + 2304u + c) * 2u);
                    float o[8];
#pragma unroll
                    for (int i = 0; i < 4; ++i) {
                        const float gl = __uint_as_float(g[i] << 16), gh = __uint_as_float(g[i] & 0xffff0000u), sl = __uint_as_float(s[i] << 16), sh = __uint_as_float(s[i] & 0xffff0000u);
                        const float zl = (2 * i < 4) ? z0[(2 * i) & 3] : z1[(2 * i) & 3], zh = (2 * i + 1 < 4) ? z0[(2 * i + 1) & 3] : z1[(2 * i + 1) & 3];
                        o[2 * i] = gl * sigm(zl) * silu(sl); o[2 * i + 1] = gh * sigm(zh) * silu(sh); }
                    u32x4 w; w.x = cvt_pk_bf16(o[0], o[1]); w.y = cvt_pk_bf16(o[2], o[3]); w.z = cvt_pk_bf16(o[4], o[5]); w.w = cvt_pk_bf16(o[6], o[7]);
                    *(u32x4*)(mxb + (row * 1024u + 512u + c) * 2u) = w;
                    asm volatile("" ::: "memory"); } }
    }
};
template <class Epi, class Sched, bool ALIGN_EPI = false, bool SP2 = false>
__device__ __forceinline__ void gemm_phase(PG8_LAS unsigned char* lds, const Gemm g, const Sched& S, const Epi& E, const int tid) {
    const int wid = __builtin_amdgcn_readfirstlane(tid >> 6), lane = tid & 63, wr = wid >> 2, wc = wid & 3, fr = lane & 15, fq = lane >> 4;
    const int K = g.K, nt = K / BK;
    unsigned voffA[2], voffB[2];
#pragma unroll
    for (int i = 0; i < 2; ++i) { int R, C; stage_rc(tid * 16 + i * 8192, R, C); const int Rb = Epi::PERM ? ((R & ~31) + perm32(R & 31)) : R;
        voffA[i] = (unsigned)(R * K + C) * 2u; voffB[i] = (unsigned)(Rb * K + C) * 2u; }
    const size_t kstep = (size_t)(BK * 2);
    const size_t hstep = (size_t)HALF * K * 2;
    const size_t tstep = 2 * hstep;
    const unsigned ldsw = (unsigned)wid * 1024u;
    const int aoff = lds_byte(wr * 64 + fr, fq * 8), boff = lds_byte(wc * 32 + fr, fq * 8);
#define PG8_SA(b, h) (((b) * 2 + (h)) * HTB)
#define PG8_SB(b, h) ((4 + (b) * 2 + (h)) * HTB)
#define PG8_STAGE(bufoff, gbase, voff) do { _Pragma("unroll") for (int _i = 0; _i < 2; ++_i) \
        __builtin_amdgcn_global_load_lds((const unsigned*)((const char*)(gbase) + (voff)[_i]), (PG8_LAS unsigned*)(lds + (bufoff) + ldsw + _i * 8192), 16, 0, 0); } while (0)
#define PG8_LDA(dst, b, h) do { _Pragma("unroll") for (int m = 0; m < 4; ++m) _Pragma("unroll") for (int k = 0; k < 2; ++k) dst[m][k] = *(const PG8_LAS bf16x8*)(lds + PG8_SA(b, h) + aoff + m * 2048 + k * 1024); } while (0)
#define PG8_LDB(dst, b, h) do { _Pragma("unroll") for (int n = 0; n < 2; ++n) _Pragma("unroll") for (int k = 0; k < 2; ++k) dst[n][k] = *(const PG8_LAS bf16x8*)(lds + PG8_SB(b, h) + boff + n * 2048 + k * 1024); } while (0)
#define PG8_MMA(ai, bj, At, Bt) do { __builtin_amdgcn_s_setprio(1); _Pragma("unroll") for (int m = 0; m < 4; ++m) _Pragma("unroll") for (int n = 0; n < 2; ++n) _Pragma("unroll") for (int k = 0; k < 2; ++k) \
        acc[ai][bj][m][n] = __builtin_amdgcn_mfma_f32_16x16x32_bf16(Bt[n][k], At[m][k], acc[ai][bj][m][n], 0, 0, 0); __builtin_amdgcn_s_setprio(0); } while (0)
#define PG8_WAIT_V(n) asm volatile("s_waitcnt vmcnt(" #n ")" ::: "memory")
#define PG8_WAIT_L(n) asm volatile("s_waitcnt lgkmcnt(" #n ")" ::: "memory")
#define PG8_BAR __builtin_amdgcn_s_barrier()
#define PG8_SCHED __builtin_amdgcn_sched_barrier(0)
    Unit cur, nxt; int ui = 0;
    if (!S.next(0, cur)) return;
    f32x4 acc[2][2][4][2];
#pragma unroll
    for (int a = 0; a < 2; ++a)
#pragma unroll
        for (int b = 0; b < 2; ++b)
#pragma unroll
            for (int m = 0; m < 4; ++m)
#pragma unroll
                for (int n = 0; n < 2; ++n) acc[a][b][m][n] = (f32x4){0.f, 0.f, 0.f, 0.f};
    bf16x8 At[4][2], B0[2][2], B1[2][2];
    const char* cA = (const char*)g.A + (size_t)cur.pm * tstep; const char* cB = (const char*)g.Bt + (size_t)cur.pn * tstep;
    S.a_ready(cur);
    if constexpr (SP2) {
        PG8_STAGE(PG8_SB(0, 0), cB, voffB); PG8_STAGE(PG8_SB(0, 1), cB + hstep, voffB); PG8_STAGE(PG8_SA(0, 0), cA, voffA); PG8_STAGE(PG8_SA(0, 1), cA + hstep, voffA);
        if (wr == 1) PG8_BAR;
        PG8_WAIT_V(2); PG8_BAR;
        PG8_STAGE(PG8_SB(1, 0), cB + kstep, voffB); PG8_STAGE(PG8_SA(1, 0), cA + kstep, voffA); PG8_STAGE(PG8_SB(1, 1), cB + hstep + kstep, voffB);
        PG8_WAIT_V(6); PG8_BAR;
    } else {
        PG8_STAGE(PG8_SB(0, 0), cB, voffB); PG8_STAGE(PG8_SA(0, 0), cA, voffA); PG8_STAGE(PG8_SB(0, 1), cB + hstep, voffB); PG8_STAGE(PG8_SA(0, 1), cA + hstep, voffA);
        if (wr == 1) PG8_BAR;
        PG8_WAIT_V(4); PG8_BAR;
        PG8_STAGE(PG8_SB(1, 0), cB + kstep, voffB); PG8_STAGE(PG8_SA(1, 0), cA + kstep, voffA); PG8_STAGE(PG8_SB(1, 1), cB + hstep + kstep, voffB);
        PG8_WAIT_V(6); PG8_BAR;
    }
    for (;;) {
        const bool has_next = S.next(ui + 1, nxt);
        const char* nA = has_next ? (const char*)g.A + (size_t)nxt.pm * tstep : cA; const char* nB = has_next ? (const char*)g.Bt + (size_t)nxt.pn * tstep : cB;
        for (int t = 0; t < nt; t += 2) {
            const bool last = (t == nt - 2);
            const char* a1 = cA + (size_t)(t + 1) * kstep;
            const char* a2 = last ? nA : cA + (size_t)(t + 2) * kstep; const char* b2 = last ? nB : cB + (size_t)(t + 2) * kstep;
            const char* a3 = a2 + kstep; const char* b3 = b2 + kstep;
            if (last && has_next) S.a_ready(nxt);
            if constexpr (SP2) {
            PG8_LDB(B0, 0, 0); PG8_LDB(B1, 0, 1); PG8_SCHED; PG8_LDA(At, 0, 0); PG8_STAGE(PG8_SA(1, 1), a1 + hstep, voffA);
            PG8_WAIT_V(8); PG8_WAIT_L(0); PG8_BAR; PG8_MMA(0, 0, At, B0); PG8_MMA(0, 1, At, B1); PG8_BAR; PG8_SCHED;
            PG8_LDA(At, 0, 1); PG8_STAGE(PG8_SB(0, 0), b2, voffB); PG8_STAGE(PG8_SB(0, 1), b2 + hstep, voffB); PG8_STAGE(PG8_SA(0, 0), a2, voffA);
            PG8_WAIT_V(8); PG8_WAIT_L(0); PG8_BAR; PG8_MMA(1, 0, At, B0); PG8_MMA(1, 1, At, B1); PG8_BAR; PG8_SCHED;
            PG8_LDB(B0, 1, 0); PG8_LDB(B1, 1, 1); PG8_SCHED; PG8_LDA(At, 1, 0); PG8_STAGE(PG8_SA(0, 1), a2 + hstep, voffA);
            PG8_WAIT_V(8); PG8_WAIT_L(0); PG8_BAR; PG8_MMA(0, 0, At, B0); PG8_MMA(0, 1, At, B1); PG8_BAR; PG8_SCHED;
            PG8_LDA(At, 1, 1); PG8_STAGE(PG8_SB(1, 0), b3, voffB); PG8_STAGE(PG8_SB(1, 1), b3 + hstep, voffB); PG8_STAGE(PG8_SA(1, 0), a3, voffA);
            PG8_WAIT_V(8); PG8_WAIT_L(0); PG8_BAR; PG8_MMA(1, 0, At, B0); PG8_MMA(1, 1, At, B1); PG8_BAR; PG8_SCHED;
            } else {
            PG8_LDB(B0, 0, 0); PG8_SCHED; PG8_LDA(At, 0, 0); PG8_STAGE(PG8_SA(1, 1), a1 + hstep, voffA);
            PG8_WAIT_L(8); PG8_BAR; PG8_WAIT_L(0); PG8_MMA(0, 0, At, B0); PG8_BAR; PG8_SCHED;
            PG8_LDB(B1, 0, 1); PG8_STAGE(PG8_SB(0, 0), b2, voffB);
            PG8_BAR; PG8_WAIT_L(0); PG8_MMA(0, 1, At, B1); PG8_BAR;
            PG8_LDA(At, 0, 1); PG8_STAGE(PG8_SA(0, 0), a2, voffA);
            PG8_BAR; PG8_WAIT_L(0); PG8_MMA(1, 0, At, B0); PG8_BAR; PG8_SCHED;
            PG8_STAGE(PG8_SB(0, 1), b2 + hstep, voffB);
            PG8_WAIT_V(6); PG8_BAR; PG8_MMA(1, 1, At, B1); PG8_BAR;
            PG8_LDB(B0, 1, 0); PG8_SCHED; PG8_LDA(At, 1, 0); PG8_STAGE(PG8_SA(0, 1), a2 + hstep, voffA);
            PG8_WAIT_L(8); PG8_BAR; PG8_WAIT_L(0); PG8_MMA(0, 0, At, B0); PG8_BAR; PG8_SCHED;
            PG8_LDB(B1, 1, 1); PG8_STAGE(PG8_SB(1, 0), b3, voffB);
            PG8_BAR; PG8_WAIT_L(0); PG8_MMA(0, 1, At, B1); PG8_BAR;
            PG8_LDA(At, 1, 1); PG8_STAGE(PG8_SA(1, 0), a3, voffA);
            PG8_BAR; PG8_WAIT_L(0); PG8_MMA(1, 0, At, B0); PG8_BAR; PG8_SCHED;
            PG8_STAGE(PG8_SB(1, 1), b3 + hstep, voffB);
            PG8_WAIT_V(6); PG8_BAR; PG8_MMA(1, 1, At, B1); PG8_BAR;
            }
        }
        if constexpr (ALIGN_EPI) { if (wr == 0) PG8_BAR; }
        if constexpr (!Epi::AFTER_DRAIN) { E(acc, cur, wr, wc, fr, fq); S.done(cur); }
        if (!has_next) break;
#pragma unroll
        for (int a = 0; a < 2; ++a)
#pragma unroll
            for (int b = 0; b < 2; ++b)
#pragma unroll
                for (int m = 0; m < 4; ++m)
#pragma unroll
                    for (int n = 0; n < 2; ++n) acc[a][b][m][n] = (f32x4){0.f, 0.f, 0.f, 0.f};
        cur = nxt; cA = nA; cB = nB; ++ui;
        if constexpr (ALIGN_EPI) { if (wr == 1) PG8_BAR; }
    }
    PG8_WAIT_V(0);
    if constexpr (!ALIGN_EPI) { if (wr == 0) PG8_BAR; }
    PG8_BAR;
    if constexpr (Epi::AFTER_DRAIN) { E.fused(acc, cur, wr, wc, fr, fq, lds, wid, lane); S.done(cur); }
#undef PG8_SA
#undef PG8_SB
#undef PG8_STAGE
#undef PG8_LDA
#undef PG8_LDB
#undef PG8_MMA
#undef PG8_WAIT_V
#undef PG8_WAIT_L
#undef PG8_BAR
#undef PG8_SCHED
}
}

constexpr int NWAVES = 8, NTHR = 512;
#ifndef MK_N_LAUNCHES
#define MK_N_LAUNCHES 1
#endif
constexpr int N_PHASES = 11;
constexpr int DM = 1024, MPROMPT = 16384, MSAMP = 128, MVALID = 16512, MPAD = 16640, SEQL = 2048, NB = 8;
constexpr int NPROJ = 3328, NPROJ_FULL = 3332;
constexpr float EPS = 1e-6f;
constexpr size_t O_Y = 0, O_PRET = 16908288, O_PHGRN = 17170432, O_PS5R = 17432576, O_PS5I = 17448960, O_PM2 = 17465344, O_PCONV = 17727488,
                 O_SRET = 17752064, O_SHGRN = 21946368, O_SS5R = 26140672, O_SS5I = 26402816, O_SM2 = 26664960, O_SCONV = 30859264, O_TOTAL = 31252480;
constexpr size_t MiB = 1u << 20;
constexpr size_t WS_CTL = 0, CTL_ZERO_BYTES = 1 * MiB;
constexpr size_t WS_WINT = 2 * MiB;
constexpr size_t WS_WOUTT = 15 * MiB;
constexpr size_t WS_WGLUT = 19 * MiB;
constexpr size_t WS_ROTC = 19 * MiB + 512 * 1024;
constexpr size_t WS_ROTS = 20 * MiB;
constexpr size_t WS_S5AB = 20 * MiB + 512 * 1024;
constexpr size_t WS_S5BB = 20 * MiB + 768 * 1024;
constexpr size_t WS_LB = 21 * MiB + 512 * 1024;
constexpr size_t WS_DT = 22 * MiB;
constexpr size_t WS_MSQ = 22 * MiB + 512 * 1024;
constexpr size_t WS_XB = 24 * MiB;
constexpr size_t WS_MIXED = 57 * MiB;
constexpr size_t WS_GY = 90 * MiB;
constexpr size_t WS_PROJ = 100 * MiB;
constexpr size_t WS_ZB = 206 * MiB;
constexpr size_t WS_S5APOW = 21 * MiB;
constexpr size_t WS_S5BBH = 21 * MiB + 256 * 1024;
constexpr size_t WS_S5CXH = 21 * MiB + 384 * 1024;
constexpr size_t WS_S5A256 = 21 * MiB + 576 * 1024;
constexpr size_t WS_PVEC = 206 * MiB;
constexpr size_t WS_M2P = 226 * MiB;
constexpr size_t WS_END = 256 * MiB;
constexpr int CW_BAR = 4096;
constexpr int RING_OFF = 0, RING_BYTES = 131072;
constexpr int LDS_BYTES = 163840;
constexpr int LDSCTL_OFF = LDS_BYTES - 512, MISC_OFF = LDSCTL_OFF + 320;

#define GAS __attribute__((address_space(1)))
#define LAS __attribute__((address_space(3)))
#define DI __device__ __forceinline__
typedef unsigned short bf16;
typedef unsigned v4u __attribute__((ext_vector_type(4)));
typedef unsigned v2u __attribute__((ext_vector_type(2)));
typedef float f32x4 __attribute__((ext_vector_type(4)));
typedef GAS unsigned gu32;
#define RLX_AGENT __ATOMIC_RELAXED, __HIP_MEMORY_SCOPE_AGENT
#define LDS_WAIT() asm volatile("s_waitcnt lgkmcnt(0)" ::: "memory")
#define VM_WAIT() asm volatile("s_waitcnt vmcnt(0)" ::: "memory")
DI unsigned f2bf(float f) { unsigned u = __builtin_bit_cast(unsigned, f); return (u + 0x7fffu + ((u >> 16) & 1u)) >> 16; }
DI unsigned pk2(float lo, float hi) { return f2bf(lo) | (f2bf(hi) << 16); }
using pg8::bf2f; using pg8::ex2; using pg8::fexp; using pg8::sigm; using pg8::silu;

#define XB_TMO      128
#define XB_XCNT(j)  (256  + 64 * (j))
#define XB_XSUB(j)  (1280 + 64 * (j))
#define XB_XGEN(j)  (2304 + 64 * (j))
#define XB_TOP      3328
#define XB_TOPGEN   3392
#define XCD_BAR_WORDS 3456
#define XB_SPIN_CAP (1u << 18)

__device__ __forceinline__ unsigned xb_ld(unsigned* p)              { return __hip_atomic_load(p, __ATOMIC_RELAXED, __HIP_MEMORY_SCOPE_AGENT); }
__device__ __forceinline__ unsigned xb_add(unsigned* p, unsigned v) { return __hip_atomic_fetch_add(p, v, __ATOMIC_RELAXED, __HIP_MEMORY_SCOPE_AGENT); }
__device__ __forceinline__ unsigned xb_xcc_id() { return (unsigned)__builtin_amdgcn_s_getreg((3 << 11) | 20) & 0xFu; }
#define XB_SPIN(cond, bar) do { unsigned _sp = 0; while (cond) { __builtin_amdgcn_s_sleep(1); \
    if ((++_sp & 255u) == 0u) { if (xb_ld(&(bar)[XB_TMO])) break; if (_sp > XB_SPIN_CAP) { atomicAdd(&(bar)[XB_TMO], 1u); break; } } } } while (0)

struct XcdBarrier {
    unsigned* bar; unsigned x;
    volatile LAS unsigned* st;
};

__device__ __forceinline__ XcdBarrier xcd_barrier_post(unsigned* bar, volatile LAS unsigned* st) {
    XcdBarrier b; b.bar = bar; b.x = xb_xcc_id(); b.st = st;
    if (threadIdx.x == 0) (void)xb_add(&bar[XB_XCNT(b.x)], 1u);
    return b;
}
__device__ __forceinline__ void xcd_barrier_complete(unsigned* bar, unsigned x, unsigned& nloc, unsigned& nx) {
    const unsigned G = gridDim.x * gridDim.y * gridDim.z;
    unsigned sum, cnt, mine, sp = 0u;
    for (;;) {
        sum = 0u; cnt = 0u; mine = 0u;
#pragma unroll
        for (unsigned j = 0; j < 16; ++j) { const unsigned c = xb_ld(&bar[XB_XCNT(j)]); sum += c; cnt += (c > 0u) ? 1u : 0u; mine = (j == x) ? c : mine; }
        if (sum == G) break;
        __builtin_amdgcn_s_sleep(1);
        if ((++sp & 255u) == 0u) { if (xb_ld(&bar[XB_TMO])) break; if (sp > XB_SPIN_CAP) { atomicAdd(&bar[XB_TMO], 1u); break; } }
    }
    nloc = mine > 0u ? mine : 1u; nx = cnt > 0u ? cnt : 1u;
}

__device__ __forceinline__ void xcd_barrier(const XcdBarrier& b) {
    asm volatile("s_waitcnt vmcnt(0)" ::: "memory");
    __syncthreads();
    if (threadIdx.x == 0) {
        unsigned* bar = b.bar;
        __builtin_amdgcn_s_waitcnt(0);
        unsigned nloc = b.st[0], nx = b.st[1];
        if (nloc == 0u) { xcd_barrier_complete(bar, b.x, nloc, nx); b.st[0] = nloc; b.st[1] = nx; }
        const unsigned old = xb_add(&bar[XB_XSUB(b.x)], 1u);
        const unsigned gen = old / nloc;
        if (old + 1u == (gen + 1u) * nloc) {
            __builtin_amdgcn_fence(__ATOMIC_RELEASE, "agent");
            asm volatile("s_waitcnt vmcnt(0)" ::: "memory");
            const unsigned og = xb_add(&bar[XB_TOP], 1u);
            const unsigned tg = og / nx;
            if (og + 1u == (tg + 1u) * nx) xb_add(&bar[XB_TOPGEN], 1u);
            else XB_SPIN(xb_ld(&bar[XB_TOPGEN]) == tg, bar);
            __builtin_amdgcn_fence(__ATOMIC_ACQUIRE, "agent");
            xb_add(&bar[XB_XGEN(b.x)], 1u);
            asm volatile("s_waitcnt vmcnt(0)" ::: "memory");
        } else {
            XB_SPIN(xb_ld(&bar[XB_XGEN(b.x)]) == gen, bar);
            __builtin_amdgcn_fence(__ATOMIC_ACQUIRE, "agent");
            asm volatile("s_waitcnt vmcnt(0)" ::: "memory");
        }
    }
    __syncthreads();
}

struct Args { const float* in[31]; float* out; unsigned char* ws; int ph_lo, ph_hi, li, pad; };
struct Frame {
    LAS unsigned char* lds; volatile LAS unsigned* MISC; gu32* ctl;
    int tid, lane, wave, vcu, G, bx, wave0;
    const float* const* ka; float* out_; unsigned char* ws_;
};
DI const float* INP(const Frame& F, int i) { const float* const* t = F.ka; asm volatile("" : "+s"(t)); return t[i]; }
DI unsigned char* WSP(const Frame& F) { unsigned char* w = F.ws_; asm volatile("" : "+s"(w)); return w; }
DI float* OUTP(const Frame& F) { float* o = F.out_; asm volatile("" : "+s"(o)); return o; }
DI float wave_sum(float v) {
#pragma unroll
    for (int o = 1; o < 64; o <<= 1) v += __shfl_xor(v, o);
    return v;
}
DI void sincos_acc(float ang, float& s, float& c) {
    const float C1 = 0.15915493667125702f, C2 = 6.4206382432985265e-09f;
    const float hi = ang * C1, lo = __builtin_fmaf(ang, C1, -hi) + ang * C2;
    const float f = (hi - __builtin_rintf(hi)) + lo;
    const float qf = __builtin_rintf(4.f * f); const int q = (int)qf;
    const float u = __builtin_fmaf(-0.25f, qf, f);
    const float r = __builtin_fmaf(u, 6.2831854820251465f, u * -1.7484555314695172e-07f);
    const float r2 = r * r;
    float sp = 2.7557319e-06f; sp = __builtin_fmaf(sp, r2, -1.9841270e-04f); sp = __builtin_fmaf(sp, r2, 8.3333333e-03f); sp = __builtin_fmaf(sp, r2, -1.6666667e-01f);
    const float sn = __builtin_fmaf(r * r2, sp, r);
    float cp = -2.7557319e-07f; cp = __builtin_fmaf(cp, r2, 2.4801587e-05f); cp = __builtin_fmaf(cp, r2, -1.3888889e-03f); cp = __builtin_fmaf(cp, r2, 4.1666667e-02f); cp = __builtin_fmaf(cp, r2, -0.5f);
    const float cs = __builtin_fmaf(r2, cp, 1.f);
    const int qq = q & 3;
    s = qq == 0 ? sn : qq == 1 ? cs : qq == 2 ? -sn : -cs;
    c = qq == 0 ? cs : qq == 1 ? -sn : qq == 2 ? -cs : sn;
}
__device__ __constant__ float ROT_INV[32] = {1.000000000e+00f, 7.498942018e-01f, 5.623413324e-01f, 4.216965139e-01f, 3.162277639e-01f, 2.371373773e-01f, 1.778279394e-01f, 1.333521456e-01f, 1.000000015e-01f, 7.498942316e-02f, 5.623413250e-02f, 4.216964915e-02f, 3.162277490e-02f, 2.371373773e-02f, 1.778279431e-02f, 1.333521400e-02f, 9.999999776e-03f, 7.498942316e-03f, 5.623413250e-03f, 4.216964822e-03f, 3.162277630e-03f, 2.371373819e-03f, 1.778279431e-03f, 1.333521446e-03f, 1.000000047e-03f, 7.498941850e-04f, 5.623413017e-04f, 4.216965172e-04f, 3.162277571e-04f, 2.371373703e-04f, 1.778279402e-04f, 1.333521504e-04f};
DI void transpose_item(const float* W, int K, int ld, int nblk, bf16* WT, LAS float* scr, int item, int lane) {
    const int kb = item / nblk, nb = item % nblk, k0 = 64 * kb, n0 = 32 * nb;
#pragma unroll 8
    for (int i = 0; i < 32; ++i) { const int kk = 2 * i + (lane >> 5); scr[kk * 33 + (lane & 31)] = W[(size_t)(k0 + kk) * ld + n0 + (lane & 31)]; }
    LDS_WAIT(); asm volatile("" ::: "memory");
    const int c = lane & 7;
#pragma unroll
    for (int j = 0; j < 4; ++j) { const int n = (lane >> 3) + 8 * j; const LAS float* s = scr + (8 * c) * 33 + n;
        v4u o; o.x = pk2(s[0 * 33], s[1 * 33]); o.y = pk2(s[2 * 33], s[3 * 33]); o.z = pk2(s[4 * 33], s[5 * 33]); o.w = pk2(s[6 * 33], s[7 * 33]);
        *(GAS v4u*)(WT + (size_t)(n0 + n) * K + k0 + 8 * c) = o; }
    LDS_WAIT(); asm volatile("" ::: "memory");
}
DI void aprep(Frame& F, int layer) {
    LAS f32x4* wdt = (LAS f32x4*)(F.lds + RING_OFF);
    const float* Win = INP(F, 9) + (size_t)layer * DM * NPROJ_FULL;
    for (int k = F.tid; k < DM; k += NTHR) wdt[k] = *(const f32x4*)(Win + (size_t)k * NPROJ_FULL + NPROJ);
    __syncthreads();
    const float* nw = INP(F, 8) + layer * DM;
    bf16* XB = (bf16*)(WSP(F) + WS_XB); float* DT = (float*)(WSP(F) + WS_DT);
    const int gw = F.vcu * NWAVES + F.wave, NGW = F.G * NWAVES, lane = F.lane;
    f32x4 nwv[4];
#pragma unroll
    for (int j = 0; j < 4; ++j) nwv[j] = *((const f32x4*)nw + lane + 64 * j);
    for (int m = gw; m < MPAD; m += NGW) {
        GAS unsigned long long* o8 = (GAS unsigned long long*)(XB + (size_t)m * DM) + lane;
        if (m >= MVALID) {
#pragma unroll
            for (int j = 0; j < 4; ++j) o8[64 * j] = 0ull;
            continue; }
        const float* src = layer == 0 ? (m < MPROMPT ? INP(F, 0) + (size_t)m * DM : INP(F, 1) + (size_t)(m - MPROMPT) * DM) : OUTP(F) + (size_t)m * DM;
        const f32x4* xr = (const f32x4*)src + lane;
        f32x4 v[4]; float ss = 0.f;
#pragma unroll
        for (int j = 0; j < 4; ++j) { v[j] = xr[64 * j]; ss += (v[j].x * v[j].x + v[j].y * v[j].y) + (v[j].z * v[j].z + v[j].w * v[j].w); }
        const float rstd = 1.f / sqrtf(wave_sum(ss) * (1.f / DM) + EPS);
        f32x4 d = (f32x4){0.f, 0.f, 0.f, 0.f};
#pragma unroll
        for (int j = 0; j < 4; ++j) { v[j] = v[j] * rstd * nwv[j];
            const int k = 4 * (lane + 64 * j);
            d += wdt[k] * v[j].x; d += wdt[k + 1] * v[j].y; d += wdt[k + 2] * v[j].z; d += wdt[k + 3] * v[j].w;
            o8[64 * j] = (unsigned long long)pk2(v[j].x, v[j].y) | ((unsigned long long)pk2(v[j].z, v[j].w) << 32); }
        d.x = wave_sum(d.x); d.y = wave_sum(d.y); d.z = wave_sum(d.z); d.w = wave_sum(d.w);
        if (lane == 0) *(f32x4*)(DT + (size_t)m * 4) = d;
    }
}
DI void final_norm(Frame& F) {
    const float* fw = INP(F, 30);
    const int gw = F.vcu * NWAVES + F.wave, NGW = F.G * NWAVES, lane = F.lane;
    f32x4 nwv[4];
#pragma unroll
    for (int j = 0; j < 4; ++j) nwv[j] = *((const f32x4*)fw + lane + 64 * j);
    for (int m = gw; m < MVALID; m += NGW) {
        f32x4* xr = (f32x4*)(OUTP(F) + (size_t)m * DM) + lane;
        f32x4 v[4]; float ss = 0.f;
#pragma unroll
        for (int j = 0; j < 4; ++j) { v[j] = xr[64 * j]; ss += (v[j].x * v[j].x + v[j].y * v[j].y) + (v[j].z * v[j].z + v[j].w * v[j].w); }
        const float rstd = 1.f / sqrtf(wave_sum(ss) * (1.f / DM) + EPS);
#pragma unroll
        for (int j = 0; j < 4; ++j) xr[64 * j] = v[j] * rstd * nwv[j];
    }
}
DI void prologue(Frame& F) {
    LAS float* scr = (LAS float*)(F.lds + RING_OFF + 16384 + F.wave * 12288);
    const int gw = F.vcu * NWAVES + F.wave, NGW = F.G * NWAVES;
    constexpr int I_IN = 16 * 104, I_OUT = 16 * 32, I_GLU = 4 * 8, I_L = I_IN + I_OUT + I_GLU;
    for (int it = gw; it < 2 * I_L; it += NGW) {
        const int l = it / I_L; int r = it % I_L;
        if (r < I_IN) { transpose_item(INP(F, 9) + (size_t)l * DM * NPROJ_FULL, DM, NPROJ_FULL, 104, (bf16*)(WSP(F) + WS_WINT) + (size_t)l * NPROJ * DM, scr, r, F.lane); continue; } r -= I_IN;
        if (r < I_OUT) { transpose_item(INP(F, 29) + (size_t)l * DM * DM, DM, DM, 32, (bf16*)(WSP(F) + WS_WOUTT) + (size_t)l * DM * DM, scr, r, F.lane); continue; } r -= I_OUT;
        transpose_item(INP(F, 21) + (size_t)l * 65536, 256, 256, 8, (bf16*)(WSP(F) + WS_WGLUT) + (size_t)l * 65536, scr, r, F.lane);
    }
    const int gt = F.vcu * NTHR + F.tid, NGT = F.G * NTHR;
    float* RC = (float*)(WSP(F) + WS_ROTC); float* RS = (float*)(WSP(F) + WS_ROTS);
    for (int idx = gt; idx < 2049 * 32; idx += NGT) {
        const int p = idx >> 5, i = idx & 31; const float pos = p < 2048 ? (float)p : 16384.f;
        const float ang = pos * ROT_INV[i];
        float s, c; sincos_acc(ang, s, c); RC[idx] = c; RS[idx] = s;
    }
    float* AB = (float*)(WSP(F) + WS_S5AB); float* BB = (float*)(WSP(F) + WS_S5BB); float* APW = (float*)(WSP(F) + WS_S5APOW); float* A2 = (float*)(WSP(F) + WS_S5A256); bf16* BBH = (bf16*)(WSP(F) + WS_S5BBH);
    for (int idx = gt; idx < 2 * 16 * 64; idx += NGT) {
        const int l = idx >> 10, g = (idx >> 6) & 15;
        const float are = INP(F, 13)[idx], aim = INP(F, 14)[idx], dt = fexp(INP(F, 15)[l * 16 + g]);
        const float mag = fexp(are * dt); float s, c; sincos_acc(aim * dt, s, c);
        const float abr = mag * c, abi = mag * s; AB[2 * idx] = abr; AB[2 * idx + 1] = abi;
        const float nr = abr - 1.f, ni = abi, den = are * are + aim * aim;
        const float fr = (nr * are + ni * aim) / den, fi = (ni * are - nr * aim) / den;
        for (int cc = 0; cc < 16; ++cc) { const float br = INP(F, 16)[(size_t)idx * 16 + cc], bi = INP(F, 17)[(size_t)idx * 16 + cc];
            const float bbr = fr * br - fi * bi, bbi = fr * bi + fi * br;
            BB[((size_t)idx * 16 + cc) * 2] = bbr; BB[((size_t)idx * 16 + cc) * 2 + 1] = bbi;
            BBH[((size_t)(((idx >> 6) * 2 + 0) * 64 + (idx & 63))) * 16 + cc] = (bf16)f2bf(bbr); BBH[((size_t)(((idx >> 6) * 2 + 1) * 64 + (idx & 63))) * 16 + cc] = (bf16)f2bf(bbi); }
        { float pr = abr, pi = abi;
          for (int i = 0; i < 16; ++i) { APW[((size_t)idx * 16 + i) * 2] = pr; APW[((size_t)idx * 16 + i) * 2 + 1] = pi; const float nr = pr * abr - pi * abi, ni = pr * abi + pi * abr; pr = nr; pi = ni; }
          float sr = abr, si = abi;
          for (int k = 0; k < 8; ++k) { const float nr = sr * sr - si * si, ni = 2.f * sr * si; sr = nr; si = ni; }
          A2[2 * idx] = sr; A2[2 * idx + 1] = si; }
    }
    { bf16* CXH = (bf16*)(WSP(F) + WS_S5CXH);
      for (int idx = gt; idx < 2 * 16 * 16 * 128; idx += NGT) { const int k = idx & 127, row = idx >> 7;
          CXH[idx] = (bf16)f2bf(k < 64 ? INP(F, 18)[(size_t)row * 64 + k] : -INP(F, 19)[(size_t)row * 64 + k - 64]); } }
    float* LB = (float*)(WSP(F) + WS_LB);
    for (int idx = gt; idx < 256; idx += NGT) {
        const float l0 = INP(F, 11)[idx], l1 = INP(F, 11)[256 + idx], mx = fmaxf(l0, l1), e0 = fexp(l0 - mx), e1 = fexp(l1 - mx);
        const float s0 = e0 / (e0 + e1), s1 = e1 / (e0 + e1);
        LB[idx] = fminf(fmaxf(s0 - s0, 0.f), 1.f); LB[256 + idx] = fminf(fmaxf((s0 + s1) - s0, 0.f), 1.f);
    }
    __syncthreads();
    aprep(F, 0);
}
DI float gelu_tanh(float x) { const float x2 = x * x; const float e = ex2(x * (x2 * -0.10294324f - 2.3022082f)); return x * __builtin_amdgcn_rcpf(1.f + e); }
DI float softplus(float x) { const float t = fexp(-fabsf(x)); const float sr = t * (1.f + t * (-0.5f + t * (0.33333333f + t * (-0.25f + t * 0.2f)))); const float lg = __builtin_amdgcn_logf(1.f + t) * 0.69314718056f; return fmaxf(x, 0.f) + (t < 0.06f ? sr : lg); }
typedef short bf16x8 __attribute__((ext_vector_type(8)));
typedef short s16x4 __attribute__((ext_vector_type(4)));
typedef short v4i16_t __attribute__((ext_vector_type(4)));
typedef float f32x16 __attribute__((ext_vector_type(16)));
typedef float f32x2v __attribute__((ext_vector_type(2)));
typedef __bf16 bf16x2v __attribute__((ext_vector_type(2)));
DI unsigned cvtpk(float lo, float hi) { f32x2v v = {lo, hi}; bf16x2v b = __builtin_convertvector(v, bf16x2v); return __builtin_bit_cast(unsigned, b); }
DI int crow(int i, int hh) { return (i & 3) + 8 * (i >> 2) + 4 * hh; }
#define MFMA32(a, b, c) __builtin_amdgcn_mfma_f32_32x32x16_bf16((a), (b), (c), 0, 0, 0)
constexpr int TP = 144, TILE_B = 64 * TP;
constexpr int VEC_OFF = 12 * TILE_B;
DI int toff(int row, int col) { return row * TP + col * 2; }
DI bf16x8 ld128(LAS unsigned char* p) { return *(LAS bf16x8*)p; }
DI s16x4 ld64(LAS unsigned char* p) { return *(LAS s16x4*)p; }
DI s16x4 ldtr(LAS unsigned char* p) { return __builtin_bit_cast(s16x4, __builtin_amdgcn_ds_read_tr16_b64_v4i16((LAS v4i16_t*)p)); }
DI bf16x8 cat8(s16x4 lo, s16x4 hi) { return __builtin_shufflevector(lo, hi, 0, 1, 2, 3, 4, 5, 6, 7); }
template <int ST> DI bf16x8 packacc(const f32x16& x) {
    v4u p; p.x = cvtpk(x[8 * ST], x[8 * ST + 1]); p.y = cvtpk(x[8 * ST + 2], x[8 * ST + 3]); p.z = cvtpk(x[8 * ST + 4], x[8 * ST + 5]); p.w = cvtpk(x[8 * ST + 6], x[8 * ST + 7]);
    return __builtin_bit_cast(bf16x8, p);
}
template <bool PERM> DI bf16x8 trfrag(LAS unsigned char* tile, int R0  , int C0, int lane) {
    const int hh = lane >> 5, q = (lane & 15) >> 2, p = lane & 3, blk = (lane >> 4) & 1;
    const int rlo = PERM ? R0 + 4 * hh + q : R0 + 8 * hh + q, rhi = PERM ? rlo + 8 : rlo + 4;
    const int col = C0 + 16 * blk + 4 * p;
    return cat8(ldtr(tile + toff(rlo, col)), ldtr(tile + toff(rhi, col)));
}
constexpr size_t WS_SLOC = 210 * MiB;
constexpr size_t WS_DTOT = 223 * MiB;
constexpr size_t WS_S5LOC = 224 * MiB;

template <int BR, bool OUT> DI void lin_unit(Frame& F, int l, int pm) {
    LAS unsigned char* L = F.lds;
    unsigned char* ws = WSP(F);
    const bf16* PJ = (const bf16*)(ws + WS_PROJ); bf16* MX = (bf16*)(ws + WS_MIXED);
    float* SLOC = (float*)(ws + WS_SLOC); float* DTOT = (float*)(ws + WS_DTOT);
    int tid_; asm volatile("v_mbcnt_lo_u32_b32 %0, -1, 0\n\tv_mbcnt_hi_u32_b32 %0, -1, %0" : "=v"(tid_)); tid_ += F.wave0 * 64;
    const int tid = tid_, lane = tid & 63, wv = __builtin_amdgcn_readfirstlane(tid >> 6), hd = wv >> 1, th = wv & 1, r = lane & 31, hh = lane >> 5;
    const int b = pm >> 3, sc = pm & 7, hid = BR * 4 + hd;
    const size_t row0 = (size_t)pm * 256;
    LAS unsigned char* Qt = L + (BR == 2 ? (2 * (hd >> 1)) : 3 * hd) * TILE_B;
    LAS unsigned char* Kt = L + (BR == 2 ? (2 * (hd >> 1) + 1) : 3 * hd + 1) * TILE_B;
    LAS unsigned char* Vt = L + (BR == 2 ? (4 + 2 * hd) : 3 * hd + 2) * TILE_B;
    LAS unsigned char* Wt = L + (5 + 2 * hd) * TILE_B;
    LAS float* ECM = (LAS float*)(L + VEC_OFF); LAS float* ETL = ECM + 256;
    LAS float* CUM = ETL + 256; LAS float* DTS = CUM + 256; LAS float* DTW = DTS + 256; LAS float* LA = DTW + 256; LAS float* SSQ = LA + 256; LAS float* TOT = SSQ + 256;
    f32x16 H[2][2];
#pragma unroll
    for (int a = 0; a < 2; ++a)
#pragma unroll
        for (int c = 0; c < 2; ++c)
#pragma unroll
            for (int i = 0; i < 16; ++i) H[a][c][i] = 0.f;
#ifndef X_NOINIT
    if (OUT) {
        for (int j = 0; j < sc; ++j) {
            const size_t u = (size_t)((pm - sc + j) * 12 + hid);
#pragma unroll
            for (int ki = 0; ki < 2; ++ki)
#pragma unroll
                for (int i = 0; i < 16; ++i) { const int k = 32 * ki + crow(i, hh); const float d = ex2(DTOT[u * 64 + k]);
#pragma unroll
                    for (int vj = 0; vj < 2; ++vj) H[ki][vj][i] = H[ki][vj][i] * d + SLOC[(u * 64 + k) * 64 + 32 * vj + r];
                    if ((i & 3) == 3) __builtin_amdgcn_sched_barrier(0); }
        }
    }
#endif
    float cx0 = 0.f, cx1 = 0.f, cx2 = 0.f;
    float dsum = 0.f;
    const float lg2 = BR == 0 ? __builtin_amdgcn_logf(1.f - ex2(-5.f - (float)hd)) : 0.f;
#pragma unroll 1
    for (int c = 0; c < 4; ++c) {
        const size_t rowc = row0 + 64 * c;
        if (!OUT) {
        if (BR == 0) {
            const int li = th * 64 + lane;
            const float* RC = (const float*)(ws + WS_ROTC); const float* RS = (const float*)(ws + WS_ROTS);
            v4u vv[4];
#pragma unroll
            for (int j = 0; j < 4; ++j) { const int id = li + 128 * j, t = id >> 3, pc = id & 7; vv[j] = *(const v4u*)(PJ + (rowc + t) * NPROJ + 512 + hd * 64 + 8 * pc); }
            v4u qa[2], qb[2], ka[2], kb[2]; f32x4 cs0[2], cs1[2], sn0[2], sn1[2];
#pragma unroll
            for (int j = 0; j < 2; ++j) { const int tk = li + 128 * j, t = tk >> 2, c0 = 8 * (tk & 3); const bf16* src = PJ + (rowc + t) * NPROJ + hd * 64 + c0; const int pos = sc * 256 + c * 64 + t;
                { qa[j] = *(const v4u*)src; qb[j] = *(const v4u*)(src + 32); }
                ka[j] = *(const v4u*)(src + 256); kb[j] = *(const v4u*)(src + 288);
                cs0[j] = *(const f32x4*)(RC + pos * 32 + c0); cs1[j] = *(const f32x4*)(RC + pos * 32 + c0 + 4); sn0[j] = *(const f32x4*)(RS + pos * 32 + c0); sn1[j] = *(const f32x4*)(RS + pos * 32 + c0 + 4); }
#pragma unroll
            for (int j = 0; j < 4; ++j) { const int id = li + 128 * j, t = id >> 3, pc = id & 7; *(LAS v4u*)(Vt + toff(t, 8 * pc)) = vv[j]; }
#pragma unroll
            for (int j = 0; j < 2; ++j) { const int tk = li + 128 * j, t = tk >> 2, c0 = 8 * (tk & 3);
#pragma unroll
                for (int which = 0; which < 2; ++which) {

                    const v4u xa = which == 0 ? qa[j] : ka[j], xb = which == 0 ? qb[j] : kb[j];
                    const float sc_ = which == 0 ? ex2((float)(t - 31) * lg2) : 0.125f * ex2((float)(31 - t) * lg2);
                    float lo[8], hi[8];
#pragma unroll
                    for (int e = 0; e < 8; ++e) { const unsigned wa = xa[e >> 1], wb = xb[e >> 1]; const float a = (e & 1) ? __uint_as_float(wa & 0xffff0000u) : __uint_as_float(wa << 16), bb = (e & 1) ? __uint_as_float(wb & 0xffff0000u) : __uint_as_float(wb << 16);
                        const float cs = e < 4 ? cs0[j][e & 3] : cs1[j][e & 3], sn = e < 4 ? sn0[j][e & 3] : sn1[j][e & 3];
                        lo[e] = (a * cs - bb * sn) * sc_; hi[e] = (a * sn + bb * cs) * sc_; }
                    v4u olo, ohi; olo.x = cvtpk(lo[0], lo[1]); olo.y = cvtpk(lo[2], lo[3]); olo.z = cvtpk(lo[4], lo[5]); olo.w = cvtpk(lo[6], lo[7]);
                    ohi.x = cvtpk(hi[0], hi[1]); ohi.y = cvtpk(hi[2], hi[3]); ohi.z = cvtpk(hi[4], hi[5]); ohi.w = cvtpk(hi[6], hi[7]);
                    LAS unsigned char* T = which == 0 ? Qt : Kt;
                    *(LAS v4u*)(T + toff(t, c0)) = olo; *(LAS v4u*)(T + toff(t, c0 + 32)) = ohi; }
            }
            if (li < 64) { ECM[hd * 64 + li] = ex2(32.f * lg2); ETL[hd * 64 + li] = ex2(32.f * lg2); }
            dsum += 64.f * lg2;
        } else if (BR == 1) {
            {
                const int li = th * 64 + lane; v4u rq[4], rf[4], rv[4];
#pragma unroll
                for (int j = 0; j < 4; ++j) { const int id = li + 128 * j, t = id >> 3, pc = id & 7; const bf16* src = PJ + (rowc + t) * NPROJ + 1024 + hd * 64 + 8 * pc;
                    rq[j] = *(const v4u*)src; rf[j] = *(const v4u*)(src + 256); rv[j] = *(const v4u*)(src + 512); }
#pragma unroll
                for (int j = 0; j < 4; ++j) { const int id = li + 128 * j, t = id >> 3, pc = id & 7;
                    *(LAS v4u*)(Qt + toff(t, 8 * pc)) = rq[j]; *(LAS v4u*)(Kt + toff(t, 8 * pc)) = rf[j]; *(LAS v4u*)(Vt + toff(t, 8 * pc)) = rv[j]; }
            }
            __syncthreads();
            const int k = lane, half = th;
            const float lb = ((const float*)(ws + WS_LB))[l * 256 + hd * 64 + k];
            float run[32]; float acc = 0.f;
#pragma unroll
            for (int t = 0; t < 32; ++t) { const float fr = bf2f(*(LAS bf16*)(Kt + toff(32 * half + t, k))); const float f = lb + (1.f - lb) * sigm(fr); acc += __builtin_amdgcn_logf(f); run[t] = acc; }
            const float tot = acc;
#pragma unroll
            for (int t = 0; t < 32; ++t) {
                const float fr = bf2f(*(LAS bf16*)(Kt + toff(32 * half + t, k)));
                const float eq = half == 0 ? run[t] - tot : run[t], ek = half == 0 ? tot - run[t] : -run[t];
                { const float gq = bf2f(*(LAS bf16*)(Qt + toff(32 * half + t, k))); *(LAS bf16*)(Qt + toff(32 * half + t, k)) = (bf16)f2bf(silu(gq) * ex2(eq)); }
                *(LAS bf16*)(Kt + toff(32 * half + t, k)) = (bf16)f2bf((1.f - lb) * sigm(-fr) * ex2(ek));
            }
            if (half == 0) ECM[hd * 64 + k] = ex2(tot); else ETL[hd * 64 + k] = ex2(tot);
            dsum += tot;
        } else {
            if (tid < 256) { const int t = tid >> 2, h = tid & 3; const float dtv = softplus(((const float*)(ws + WS_DT))[(rowc + t) * 4 + h] + INP(F, 25)[l * 4 + h]);
                DTS[h * 64 + t] = dtv; LA[h * 64 + t] = dtv * (-fexp(INP(F, 26)[l * 4 + h])) * 1.4426950408889634f; }
            { v4u rw[8];
#pragma unroll
              for (int j = 0; j < 8; ++j) { const int id = tid + 512 * j, t = id >> 6, pc = id & 63; rw[j] = *(const v4u*)(PJ + (rowc + t) * NPROJ + 2816 + 8 * pc); }
#pragma unroll
              for (int j = 0; j < 8; ++j) { const int id = tid + 512 * j, t = id >> 6, pc = id & 63;
                  LAS unsigned char* T = pc < 32 ? L + (4 + 2 * (pc >> 3)) * TILE_B : pc < 48 ? L + (2 * ((pc >> 3) & 1) + 1) * TILE_B : L + (2 * ((pc >> 3) & 1)) * TILE_B;
                  *(LAS v4u*)(T + toff(t, 8 * (pc & 7))) = rw[j]; } }
            __syncthreads();
            if (wv == 0) {
#pragma unroll
                for (int h = 0; h < 4; ++h) { float v = LA[h * 64 + lane];
#pragma unroll
                    for (int o = 1; o < 64; o <<= 1) { const float u = __shfl_up(v, o); if (lane >= o) v += u; }
                    const float tot = __shfl(v, 63); CUM[h * 64 + lane] = v; DTW[h * 64 + lane] = DTS[h * 64 + lane] * ex2(tot - v); if (lane == 0) TOT[h] = tot; }
            }
            __syncthreads();
            { const int cc = tid; const float* cw = INP(F, 23) + l * 2048; const float w0 = cw[cc], w1 = cw[512 + cc], w2 = cw[1024 + cc], w3 = cw[1536 + cc], cb = INP(F, 24)[l * 512 + cc];
              const int role = cc >> 8 == 0 ? 0 : (cc < 384 ? 1 : 2), hx = cc >> 6, n = cc & 63, g = (cc >> 6) & 1;
              LAS unsigned char* T1 = role == 0 ? L + (4 + 2 * hx) * TILE_B : role == 1 ? L + (2 * g + 1) * TILE_B : L + (2 * g) * TILE_B;
              LAS unsigned char* T2 = L + (5 + 2 * (hx & 3)) * TILE_B;
              if (c == 0) { const bf16* src = PJ + rowc * NPROJ + 2816 + cc; const bool hv = sc > 0;
                  cx0 = hv ? bf2f(*(src - 3 * (ptrdiff_t)NPROJ)) : 0.f; cx1 = hv ? bf2f(*(src - 2 * (ptrdiff_t)NPROJ)) : 0.f; cx2 = hv ? bf2f(*(src - (ptrdiff_t)NPROJ)) : 0.f; }
              {
#pragma unroll 8
              for (int t = 0; t < 64; ++t) { const float x3 = bf2f(*(LAS bf16*)(T1 + toff(t, n))); const float y = silu(cb + w0 * cx0 + w1 * cx1 + w2 * cx2 + w3 * x3); cx0 = cx1; cx1 = cx2; cx2 = x3;
                  *(LAS bf16*)(T1 + toff(t, n)) = (bf16)f2bf(y);
                  if (role == 0) *(LAS bf16*)(T2 + toff(t, n)) = (bf16)f2bf(y * DTW[hx * 64 + t]); } }
            }
        }
        __syncthreads();
        {
            bf16* M2P = (bf16*)(ws + WS_M2P); float* PV = (float*)(ws + WS_PVEC) + (size_t)(pm * 4 + c) * 2048 + (BR == 2 ? 1024 : 0);
            if (BR != 2) { const int li = th * 64 + lane;
#pragma unroll
                for (int j = 0; j < 4; ++j) { const int id = li + 128 * j, t = id >> 3, pc = id & 7; bf16* dst = (bf16*)PJ + (rowc + t) * NPROJ + (BR == 0 ? 0 : 1024) + hd * 64 + 8 * pc;
                    *(v4u*)dst = *(LAS v4u*)(Qt + toff(t, 8 * pc)); *(v4u*)(dst + 256) = *(LAS v4u*)(Kt + toff(t, 8 * pc)); }
                if (BR == 1 && tid < 128) { const f32x4 e = *(LAS f32x4*)(ECM + 4 * tid); *(f32x4*)(PV + 4 * tid) = e; }
            } else {
#pragma unroll
                for (int j = 0; j < 12; ++j) { const int id = tid + 512 * j, t = (id >> 3) & 63, pc = id & 7, tile = id >> 9;
                    const int col = tile < 4 ? ((tile & 1) ? 512 : 640) + (tile >> 1) * 64 : ((tile & 1) ? 256 : 0) + ((tile - 4) >> 1) * 64;
                    *(v4u*)(M2P + (rowc + t) * 768 + col + 8 * pc) = *(LAS v4u*)(L + tile * TILE_B + toff(t, 8 * pc)); }
                if (tid < 128) { const f32x4 e = *(LAS f32x4*)(CUM + 4 * tid); *(f32x4*)(PV + 4 * tid) = e; }
                if (tid < 4) PV[512 + tid] = TOT[tid];
            }
        }
        } else {
            const bf16* M2P = (const bf16*)(ws + WS_M2P); const float* PV = (const float*)(ws + WS_PVEC) + (size_t)(pm * 4 + c) * 2048 + (BR == 2 ? 1024 : 0);
            v4u tl[12];
#pragma unroll
            for (int j = 0; j < 12; ++j) { const int id = tid + 512 * j, t = (id >> 3) & 63, pc = id & 7, tile = id >> 9;
                if (BR != 2) { const int hx = tile / 3, w = tile % 3; tl[j] = *(const v4u*)(PJ + (rowc + t) * NPROJ + (BR == 0 ? 0 : 1024) + w * 256 + hx * 64 + 8 * pc); }
                else { const int col = tile < 4 ? ((tile & 1) ? 512 : 640) + (tile >> 1) * 64 : ((tile & 1) ? 256 : 0) + ((tile - 4) >> 1) * 64; tl[j] = *(const v4u*)(M2P + (rowc + t) * 768 + col + 8 * pc); } }
            f32x4 pv4 = {0.f, 0.f, 0.f, 0.f}; float tv = 0.f;
            if (BR != 0 && tid < 128) pv4 = *(const f32x4*)(PV + 4 * tid);
            if (BR == 2 && tid < 4) tv = PV[512 + tid];
#pragma unroll
            for (int j = 0; j < 12; ++j) { const int id = tid + 512 * j, t = (id >> 3) & 63, pc = id & 7, tile = id >> 9; *(LAS v4u*)(L + tile * TILE_B + toff(t, 8 * pc)) = tl[j]; }
            if (BR == 0) { if (tid < 256) { ECM[tid] = ex2(32.f * __builtin_amdgcn_logf(1.f - 1.f / (float)(32 << (tid >> 6)))); ETL[tid] = ECM[tid]; } }
            else if (tid < 128) *(LAS f32x4*)((BR == 1 ? ECM : CUM) + 4 * tid) = pv4;
            if (BR == 2 && tid < 4) TOT[tid] = tv;
        }
        __syncthreads();
        if (BR == 2) dsum += TOT[hd];
        f32x16 OT[2];
#pragma unroll
        for (int i = 0; i < 16; ++i) { OT[0][i] = 0.f; OT[1][i] = 0.f; }
        if (BR != 2) {
#pragma unroll
            for (int ki = 0; ki < 2; ++ki)
#pragma unroll
                for (int g4 = 0; g4 < 4; ++g4) { const f32x4 e4 = *(LAS f32x4*)(ECM + hd * 64 + 32 * ki + 8 * g4 + 4 * hh);
#pragma unroll
                    for (int e = 0; e < 4; ++e) { H[ki][0][4 * g4 + e] *= e4[e]; H[ki][1][4 * g4 + e] *= e4[e]; } }
        }
        if (OUT) {
#pragma unroll
            for (int ki = 0; ki < 2; ++ki) {
                const bf16x8 q0 = cat8(ld64(Qt + toff(32 * th + r, 32 * ki + 4 * hh)), ld64(Qt + toff(32 * th + r, 32 * ki + 8 + 4 * hh)));
                const bf16x8 q1 = cat8(ld64(Qt + toff(32 * th + r, 32 * ki + 16 + 4 * hh)), ld64(Qt + toff(32 * th + r, 32 * ki + 24 + 4 * hh)));
#pragma unroll
                for (int vj = 0; vj < 2; ++vj) { OT[vj] = MFMA32(packacc<0>(H[ki][vj]), q0, OT[vj]); OT[vj] = MFMA32(packacc<1>(H[ki][vj]), q1, OT[vj]); }
            }
            if (BR == 2) { const float ect = ex2(CUM[hd * 64 + 32 * th + r]);
#pragma unroll
                for (int i = 0; i < 16; ++i) { OT[0][i] *= ect; OT[1][i] *= ect; } }
            __builtin_amdgcn_sched_barrier(0);
#pragma unroll
            for (int si = 0; si < 2; ++si) {
                if (si > th) continue;
                f32x16 ST;
#pragma unroll
                for (int i = 0; i < 16; ++i) ST[i] = 0.f;
#pragma unroll
                for (int ks = 0; ks < 4; ++ks) ST = MFMA32(ld128(Kt + toff(32 * si + r, 16 * ks + 8 * hh)), ld128(Qt + toff(32 * th + r, 16 * ks + 8 * hh)), ST);
                if (BR == 2) { const float ct = CUM[hd * 64 + 32 * th + r];
#pragma unroll
                    for (int g4 = 0; g4 < 4; ++g4) { const f32x4 cs = *(LAS f32x4*)(CUM + hd * 64 + 32 * si + 8 * g4 + 4 * hh), ds = *(LAS f32x4*)(DTS + hd * 64 + 32 * si + 8 * g4 + 4 * hh);
#pragma unroll
                        for (int e = 0; e < 4; ++e) { const int i = 4 * g4 + e; const bool keep = (si < th) || (crow(i, hh) <= r); ST[i] = keep ? ST[i] * ex2(ct - cs[e]) * ds[e] : 0.f; } }
                } else if (si == th) {
#pragma unroll
                    for (int i = 0; i < 16; ++i) ST[i] = (crow(i, hh) <= r) ? ST[i] : 0.f;
                }
                __builtin_amdgcn_sched_barrier(0);
                const bf16x8 p0 = packacc<0>(ST), p1 = packacc<1>(ST);
#pragma unroll
                for (int vi = 0; vi < 2; ++vi) { OT[vi] = MFMA32(trfrag<true>(Vt, 32 * si, 32 * vi, lane), p0, OT[vi]); OT[vi] = MFMA32(trfrag<true>(Vt, 32 * si + 16, 32 * vi, lane), p1, OT[vi]); }
            }
        }
        __builtin_amdgcn_sched_barrier(0);
        if (BR == 2) { const float et = ex2(TOT[hd]);
#pragma unroll
            for (int i = 0; i < 16; ++i) { H[0][0][i] *= et; H[0][1][i] *= et; H[1][0][i] *= et; H[1][1][i] *= et; } }
#pragma unroll
        for (int s4 = 0; s4 < 4; ++s4) {
            const bf16x8 a0 = trfrag<false>(Kt, 16 * s4, 0, lane), a1 = trfrag<false>(Kt, 16 * s4, 32, lane);
            LAS unsigned char* VV = BR == 2 ? Wt : Vt;
            const bf16x8 b0 = trfrag<false>(VV, 16 * s4, 0, lane), b1 = trfrag<false>(VV, 16 * s4, 32, lane);
            H[0][0] = MFMA32(a0, b0, H[0][0]); H[0][1] = MFMA32(a0, b1, H[0][1]); H[1][0] = MFMA32(a1, b0, H[1][0]); H[1][1] = MFMA32(a1, b1, H[1][1]);
            __builtin_amdgcn_sched_barrier(0);
        }
        if (BR != 2) {
#pragma unroll
            for (int ki = 0; ki < 2; ++ki)
#pragma unroll
                for (int g4 = 0; g4 < 4; ++g4) { const f32x4 e4 = *(LAS f32x4*)(ETL + hd * 64 + 32 * ki + 8 * g4 + 4 * hh);
#pragma unroll
                    for (int e = 0; e < 4; ++e) { H[ki][0][4 * g4 + e] *= e4[e]; H[ki][1][4 * g4 + e] *= e4[e]; } }
        }
        __builtin_amdgcn_sched_barrier(0);
#ifdef X_NOEPI
        if (OUT) { asm volatile("" :: "v"(OT[0]), "v"(OT[1])); }
        if (false) {
#else
        if (OUT) {
#endif
            const size_t rowt = rowc + 32 * th + r;
            float ss = 0.f;
            if (BR == 2) { const float Dh = INP(F, 27)[l * 4 + hd];
#pragma unroll
                for (int vi = 0; vi < 2; ++vi)
#pragma unroll
                    for (int g4 = 0; g4 < 4; ++g4) { const int v0 = 32 * vi + 8 * g4 + 4 * hh;
                        const v2u xz = *(LAS v2u*)(Vt + toff(32 * th + r, v0)); const v2u zz = *(const v2u*)(PJ + rowt * NPROJ + 2560 + hd * 64 + v0);
#pragma unroll
                        for (int e = 0; e < 4; ++e) { const unsigned xw = xz[e >> 1], zw = zz[e >> 1]; const float x = (e & 1) ? __uint_as_float(xw & 0xffff0000u) : __uint_as_float(xw << 16), z = (e & 1) ? __uint_as_float(zw & 0xffff0000u) : __uint_as_float(zw << 16);
                            const float my = (OT[vi][4 * g4 + e] + Dh * x) * silu(z); OT[vi][4 * g4 + e] = my; ss += my * my; } }
                ss += __shfl_xor(ss, 32);
                if (hh == 0) SSQ[hd * 64 + 32 * th + r] = ss;
                __syncthreads();
                ss = (SSQ[32 * th + r] + SSQ[64 + 32 * th + r]) + (SSQ[128 + 32 * th + r] + SSQ[192 + 32 * th + r]);
            } else {
#pragma unroll
                for (int i = 0; i < 16; ++i) ss += OT[0][i] * OT[0][i] + OT[1][i] * OT[1][i];
                ss += __shfl_xor(ss, 32);
            }
            const float rs = 1.f / sqrtf(ss * (BR == 2 ? 1.f / 256.f : 1.f / 64.f) + EPS);
            const float* nw = INP(F, BR == 0 ? 10 : BR == 1 ? 12 : 28) + l * 256 + hd * 64;
            LAS unsigned char* STG = BR == 2 ? Vt : Qt;
#pragma unroll
            for (int vi = 0; vi < 2; ++vi)
#pragma unroll
                for (int g4 = 0; g4 < 4; ++g4) { const int v0 = 32 * vi + 8 * g4 + 4 * hh; const f32x4 w4 = *(const f32x4*)(nw + v0);
                    float o[4];
                    if (BR == 2) {
#pragma unroll
                        for (int e = 0; e < 4; ++e) o[e] = OT[vi][4 * g4 + e] * rs * w4[e];
                    } else { const v2u gz = *(const v2u*)(PJ + rowt * NPROJ + (BR == 0 ? 768 : 1792) + hd * 64 + v0);
#pragma unroll
                        for (int e = 0; e < 4; ++e) { const unsigned gw = gz[e >> 1]; const float g = (e & 1) ? __uint_as_float(gw & 0xffff0000u) : __uint_as_float(gw << 16); o[e] = OT[vi][4 * g4 + e] * rs * w4[e] * silu(g); } }
                    v2u pk; pk.x = cvtpk(o[0], o[1]); pk.y = cvtpk(o[2], o[3]);
                    *(LAS v2u*)(STG + toff(32 * th + r, v0)) = pk; __builtin_amdgcn_sched_barrier(0); }
            LDS_WAIT();
#pragma unroll
            for (int it = 0; it < 4; ++it) { const int rw = it * 8 + (lane >> 3), pc = lane & 7;
                const v4u v = *(LAS v4u*)(STG + toff(32 * th + rw, 8 * pc));
                *(v4u*)(MX + (rowc + 32 * th + rw) * DM + (BR == 0 ? 0 : BR == 1 ? 256 : 768) + hd * 64 + 8 * pc) = v; }
        }
        __syncthreads();
    }
    if (!OUT) {
        const size_t u = (size_t)(pm * 12 + hid);
        if (th == 0) {
#pragma unroll
            for (int ki = 0; ki < 2; ++ki)
#pragma unroll
                for (int vj = 0; vj < 2; ++vj)
#pragma unroll
                    for (int i = 0; i < 16; ++i) SLOC[(u * 64 + 32 * ki + crow(i, hh)) * 64 + 32 * vj + r] = H[ki][vj][i];
        }
        if (BR == 1) { LAS float* XC = ECM;
            if (th == 1) XC[hd * 64 + lane] = dsum;
            __syncthreads();
            if (th == 0) DTOT[u * 64 + lane] = dsum + XC[hd * 64 + lane];
        } else if (th == 0) DTOT[u * 64 + lane] = dsum;
    } else if (sc == 7) {
        float* ho = OUTP(F) + (BR == 0 ? O_PRET : BR == 1 ? O_PHGRN : O_PM2) + (size_t)((l * NB + b) * 4 + hd) * 4096;
        if (th == 0) {
#pragma unroll
            for (int ki = 0; ki < 2; ++ki)
#pragma unroll
                for (int vj = 0; vj < 2; ++vj)
#pragma unroll
                    for (int i = 0; i < 16; ++i) ho[(32 * ki + crow(i, hh)) * 64 + 32 * vj + r] = H[ki][vj][i];
        }
        if (BR == 2) { float* cbo = OUTP(F) + O_PCONV + (size_t)(l * NB + b) * 1536;
            for (int e = tid; e < 1536; e += NTHR) { const int i = e / 512, cc = e % 512; cbo[e] = bf2f(PJ[(row0 + 253 + i) * NPROJ + 2816 + cc]); } }
    }
}

typedef float f32x4v __attribute__((ext_vector_type(4)));
#define MFMA16(a, b, c) __builtin_amdgcn_mfma_f32_16x16x32_bf16((a), (b), (c), 0, 0, 0)
constexpr int S5_IMG = 0, S5_GY = 65536, S5_GYP = 528;
template <bool OUT> DI void s5_mfma_unit(Frame& F, int l, int pm) {
    LAS unsigned char* L = F.lds; unsigned char* ws = WSP(F);
    int tid_; asm volatile("v_mbcnt_lo_u32_b32 %0, -1, 0\n\tv_mbcnt_hi_u32_b32 %0, -1, %0" : "=v"(tid_)); tid_ += F.wave0 * 64;
    const int tid = tid_, lane = tid & 63, wv = __builtin_amdgcn_readfirstlane(tid >> 6), r = lane & 31, hh = lane >> 5;
    const int b = pm >> 3, sc = pm & 7; const size_t row0 = (size_t)pm * 256;
    const bf16* PJ = (const bf16*)(ws + WS_PROJ); bf16* MX = (bf16*)(ws + WS_MIXED);
    const float* AB = (const float*)(ws + WS_S5AB); const float* APOW = (const float*)(ws + WS_S5APOW); const float* A256 = (const float*)(ws + WS_S5A256);
    const bf16* BBH = (const bf16*)(ws + WS_S5BBH); const bf16* CXH = (const bf16*)(ws + WS_S5CXH); float* ELOC = (float*)(ws + WS_S5LOC);
    LAS unsigned char* IMR = L + S5_IMG + wv * 8192; LAS unsigned char* IMI = IMR + 4096;
    LAS unsigned char* GYT = L + S5_GY;
    const int ireg_ = (r & 3) + 4 * (r >> 3); const int trow = 16 * ((r >> 2) & 1) + 8 * (ireg_ & 1) + (ireg_ >> 1);
    float cr[2][2], ci[2][2];
#pragma unroll
    for (int gg = 0; gg < 2; ++gg)
#pragma unroll
        for (int ph = 0; ph < 2; ++ph) { cr[gg][ph] = 0.f; ci[gg][ph] = 0.f; }
    if (OUT) {
        for (int j = 0; j < sc; ++j)
#pragma unroll
            for (int gg = 0; gg < 2; ++gg)
#pragma unroll
                for (int ph = 0; ph < 2; ++ph) { const int g = 2 * wv + gg, p = 32 * ph + r; const size_t ix = (size_t)((l * 16 + g) * 64 + p) * 2;
                    const float ar = A256[ix], ai = A256[ix + 1]; const float* e = ELOC + (size_t)(((pm - sc + j) * 16 + g) * 64 + p) * 2;
                    const float nr = ar * cr[gg][ph] - ai * ci[gg][ph] + e[0], ni = ar * ci[gg][ph] + ai * cr[gg][ph] + e[1]; cr[gg][ph] = nr; ci[gg][ph] = ni; }
    }
#pragma unroll 1
    for (int c4 = 0; c4 < 4; ++c4) {
        const size_t rowc = row0 + 64 * c4;
#if defined(PROBE_S5) && PROBE_S5 == 1
        float sv_[8] = {cr[0][0], ci[0][0], cr[0][1], ci[0][1], cr[1][0], ci[1][0], cr[1][1], ci[1][1]};
#pragma unroll 1
        for (int rep_ = 0; rep_ < (OUT ? 2 : 1); ++rep_) { if (rep_) { cr[0][0] = sv_[0]; ci[0][0] = sv_[1]; cr[0][1] = sv_[2]; ci[0][1] = sv_[3]; cr[1][0] = sv_[4]; ci[1][0] = sv_[5]; cr[1][1] = sv_[6]; ci[1][1] = sv_[7]; }
#else
        {
#endif
#pragma unroll 1
        for (int gg = 0; gg < 2; ++gg) {
            const int g = 2 * wv + gg;
            float cr0 = gg == 0 ? cr[0][0] : cr[1][0], ci0 = gg == 0 ? ci[0][0] : ci[1][0], cr1 = gg == 0 ? cr[0][1] : cr[1][1], ci1 = gg == 0 ? ci[0][1] : ci[1][1];
            bf16x8 bbf[2][2]; bf16x8 cxf[4];
#pragma unroll
            for (int ph = 0; ph < 2; ++ph)
#pragma unroll
                for (int ri = 0; ri < 2; ++ri) bbf[ph][ri] = *(const bf16x8*)(BBH + ((size_t)(((l * 16 + g) * 2 + ri) * 64 + 32 * ph + r)) * 16 + 8 * hh);
            if (OUT) {
#pragma unroll
                for (int ks = 0; ks < 4; ++ks) cxf[ks] = *(const bf16x8*)(CXH + ((size_t)((l * 16 + g) * 16 + (lane & 15))) * 128 + 32 * ks + 8 * (lane >> 4));
            }
            float arr[2], aii[2]; bf16x8 uav[2]; v2u u4v[2][2]; f32x4v d4 = {0.f, 0.f, 0.f, 0.f};
#pragma unroll
            for (int ph = 0; ph < 2; ++ph) { const size_t ix = (size_t)((l * 16 + g) * 64 + 32 * ph + r); arr[ph] = AB[2 * ix]; aii[ph] = AB[2 * ix + 1];
                }
#pragma unroll
            for (int tl = 0; tl < 2; ++tl) { uav[tl] = *(const bf16x8*)(PJ + (rowc + 32 * tl + trow) * NPROJ + 2048 + g * 16 + 8 * hh);
                if (OUT) {
#pragma unroll
                    for (int tt = 0; tt < 2; ++tt) u4v[tl][tt] = *(const v2u*)(PJ + (rowc + 32 * tl + 16 * tt + 8 * (lane & 1) + ((lane & 15) >> 1)) * NPROJ + 2048 + g * 16 + 4 * (lane >> 4)); } }
            if (OUT) d4 = *(const f32x4v*)(INP(F, 20) + l * 256 + g * 16 + 4 * (lane >> 4));
#pragma unroll
            for (int tl = 0; tl < 2; ++tl) {
                const bf16x8 ua = uav[tl];
#pragma unroll
                for (int ph = 0; ph < 2; ++ph) {
                    const float ar = arr[ph], ai = aii[ph];
                    float a2r = ar * ar - ai * ai, a2i = 2.f * ar * ai; const float a4r = a2r * a2r - a2i * a2i, a4i = 2.f * a2r * a2i; const float a8r = a4r * a4r - a4i * a4i, a8i = 2.f * a4r * a4i;
                    f32x16 zr;
#pragma unroll
                    for (int i = 0; i < 16; ++i) zr[i] = 0.f;
                    f32x16 bre = MFMA32(ua, bbf[ph][0], zr), bim = MFMA32(ua, bbf[ph][1], zr);
                    f32x2v hr2 = {0.f, 0.f}, hi2 = {0.f, 0.f};
#pragma unroll
                    for (int j = 0; j < 8; ++j) { const f32x2v br2 = {bre[2 * j], bre[2 * j + 1]}, bi2 = {bim[2 * j], bim[2 * j + 1]};
                        const f32x2v nr = ar * hr2 + (br2 - ai * hi2), ni = ar * hi2 + (ai * hr2 + bi2); hr2 = nr; hi2 = ni;
                        bre[2 * j] = nr.x; bre[2 * j + 1] = nr.y; bim[2 * j] = ni.x; bim[2 * j + 1] = ni.y; }
                    const float oAr = __shfl_xor(hr2.x, 32), oAi = __shfl_xor(hi2.x, 32), oBr = __shfl_xor(hr2.y, 32), oBi = __shfl_xor(hi2.y, 32);
                    const float eA0r = hh ? oAr : hr2.x, eA0i = hh ? oAi : hi2.x, eB0r = hh ? oBr : hr2.y, eB0i = hh ? oBi : hi2.y;
                    const float eA1r = hh ? hr2.x : oAr, eA1i = hh ? hi2.x : oAi, eB1r = hh ? hr2.y : oBr, eB1i = hh ? hi2.y : oBi;
                    float& ccr = ph == 0 ? cr0 : cr1; float& cci = ph == 0 ? ci0 : ci1;
                    const float t0r = a8r * ccr - a8i * cci + eA0r, t0i = a8r * cci + a8i * ccr + eA0i;
                    const float t1r = a8r * t0r - a8i * t0i + eB0r, t1i = a8r * t0i + a8i * t0r + eB0i;
                    const float t2r = a8r * t1r - a8i * t1i + eA1r, t2i = a8r * t1i + a8i * t1r + eA1i;
                    const float t3r = a8r * t2r - a8i * t2i + eB1r, t3i = a8r * t2i + a8i * t2r + eB1i;
                    if (OUT) {
                        const f32x2v c2r = {hh ? t1r : ccr, hh ? t2r : t0r}, c2i = {hh ? t1i : cci, hh ? t2i : t0i};
                        f32x2v wr2 = ar * c2r - ai * c2i, wi2 = ar * c2i + ai * c2r;
#pragma unroll
                        for (int j = 0; j < 8; ++j) { bre[2 * j] += wr2.x; bre[2 * j + 1] += wr2.y; bim[2 * j] += wi2.x; bim[2 * j + 1] += wi2.y;
                            const f32x2v nr = ar * wr2 - ai * wi2, ni = ar * wi2 + ai * wr2; wr2 = nr; wi2 = ni; }
#pragma unroll
                        for (int g4 = 0; g4 < 4; ++g4) { v2u pr2, pi2; pr2.x = cvtpk(bre[4 * g4], bre[4 * g4 + 1]); pr2.y = cvtpk(bre[4 * g4 + 2], bre[4 * g4 + 3]); pi2.x = cvtpk(bim[4 * g4], bim[4 * g4 + 1]); pi2.y = cvtpk(bim[4 * g4 + 2], bim[4 * g4 + 3]);
                            *(LAS v2u*)(IMR + (32 * ph + r) * 64 + (16 * hh + 4 * g4) * 2) = pr2; *(LAS v2u*)(IMI + (32 * ph + r) * 64 + (16 * hh + 4 * g4) * 2) = pi2; }
                    }
                    ccr = t3r; cci = t3i;
                }
                if (OUT) {
                    LDS_WAIT();
                    const int gi = lane >> 4, q = (lane & 15) >> 2, pp = lane & 3;
#pragma unroll
                    for (int tt = 0; tt < 2; ++tt) {
                        f32x4v y = {0.f, 0.f, 0.f, 0.f};
#pragma unroll
                        for (int ks = 0; ks < 4; ++ks) { LAS unsigned char* im = (ks < 2 ? IMR : IMI) + (32 * (ks & 1) + 8 * gi + q) * 64 + (16 * tt + 4 * pp) * 2;
                            y = MFMA16(cxf[ks], cat8(ldtr(im), ldtr(im + 4 * 64)), y); }
                        const int t = 32 * tl + 16 * tt + 8 * (lane & 1) + ((lane & 15) >> 1);
                        const v2u u4 = u4v[tl][tt];
                        float o[4];
#pragma unroll
                        for (int e = 0; e < 4; ++e) { const unsigned uw = u4[e >> 1]; const float u = (e & 1) ? __uint_as_float(uw & 0xffff0000u) : __uint_as_float(uw << 16); o[e] = gelu_tanh(y[e] + d4[e] * u); }
                        v2u pk; pk.x = cvtpk(o[0], o[1]); pk.y = cvtpk(o[2], o[3]);
                        *(LAS v2u*)(GYT + t * S5_GYP + (g * 16 + 4 * gi) * 2) = pk; }
                    LDS_WAIT();
                }
            }
            if (gg == 0) { cr[0][0] = cr0; ci[0][0] = ci0; cr[0][1] = cr1; ci[0][1] = ci1; } else { cr[1][0] = cr0; ci[1][0] = ci0; cr[1][1] = cr1; ci[1][1] = ci1; }
        }
        }
        if (OUT) {
            bf16x8 wg[16];
            { const bf16* WG0 = (const bf16*)(ws + WS_WGLUT) + (size_t)l * 65536 + (size_t)(32 * wv + r) * 256 + 8 * hh;
#pragma unroll
              for (int ks = 0; ks < 16; ++ks) wg[ks] = *(const bf16x8*)(WG0 + 16 * ks); }
#if defined(PROBE_S5) && PROBE_S5 == 2
#pragma unroll 1
            for (int rep_ = 0; rep_ < 2; ++rep_) {
#else
            {
#endif
            __syncthreads();
            LAS unsigned char* STG = IMR;
#pragma unroll 1
            for (int t2 = 0; t2 < 2; ++t2) {
                f32x16 Z;
#pragma unroll
                for (int i = 0; i < 16; ++i) Z[i] = 0.f;
#pragma unroll
                for (int ks = 0; ks < 16; ++ks) Z = MFMA32(wg[ks], ld128(GYT + (32 * t2 + r) * S5_GYP + (16 * ks + 8 * hh) * 2), Z);
                const int t = 32 * t2 + r;
#pragma unroll
                for (int g4 = 0; g4 < 4; ++g4) { const int n0 = 32 * wv + 8 * g4 + 4 * hh;
                    const v2u gy2 = *(LAS v2u*)(GYT + t * S5_GYP + n0 * 2); const v2u sg2 = *(const v2u*)(PJ + (rowc + t) * NPROJ + 2304 + n0); const f32x4v b4 = *(const f32x4v*)(INP(F, 22) + l * 256 + n0);
                    float o[4];
#pragma unroll
                    for (int e = 0; e < 4; ++e) { const unsigned gw = gy2[e >> 1], sw = sg2[e >> 1]; const float gy = (e & 1) ? __uint_as_float(gw & 0xffff0000u) : __uint_as_float(gw << 16), sg = (e & 1) ? __uint_as_float(sw & 0xffff0000u) : __uint_as_float(sw << 16);
                        const float ez = ex2((Z[4 * g4 + e] + b4[e]) * -1.4426950408889634f), es = ex2(sg * -1.4426950408889634f);
                        o[e] = gy * sg * __builtin_amdgcn_rcpf((1.f + ez) * (1.f + es)); }
                    v2u pk; pk.x = cvtpk(o[0], o[1]); pk.y = cvtpk(o[2], o[3]);
                    *(LAS v2u*)(STG + t * 80 + (8 * g4 + 4 * hh) * 2) = pk; }
            }
            LDS_WAIT();
#pragma unroll
            for (int it = 0; it < 4; ++it) { const int rw = it * 16 + (lane >> 2), pc = lane & 3;
                const v4u v = *(LAS v4u*)(STG + rw * 80 + pc * 16);
                *(v4u*)(MX + (rowc + rw) * DM + 512 + 32 * wv + 8 * pc) = v; }
            __syncthreads();
            }
        }
    }
    if (!OUT) {
        if (hh == 0) {
#pragma unroll
            for (int gg = 0; gg < 2; ++gg)
#pragma unroll
                for (int ph = 0; ph < 2; ++ph) { float* e = ELOC + (size_t)((pm * 16 + 2 * wv + gg) * 64 + 32 * ph + r) * 2; e[0] = cr[gg][ph]; e[1] = ci[gg][ph]; }
        }
    } else if (sc == 7 && hh == 0) {
        float* out = OUTP(F);
#pragma unroll
        for (int gg = 0; gg < 2; ++gg)
#pragma unroll
            for (int ph = 0; ph < 2; ++ph) { const size_t o = (size_t)((l * NB + b) * 16 + 2 * wv + gg) * 64 + 32 * ph + r; out[O_PS5R + o] = cr[gg][ph]; out[O_PS5I + o] = ci[gg][ph]; }
    }
}

DI void sample_unit(Frame& F, int l, int s) {
    int tid_; asm volatile("v_mbcnt_lo_u32_b32 %0, -1, 0\n\tv_mbcnt_hi_u32_b32 %0, -1, %0" : "=v"(tid_)); tid_ += F.wave0 * 64;
    const int tid = tid_, lane = tid & 63, wv = __builtin_amdgcn_readfirstlane(tid >> 6);
    unsigned char* ws = WSP(F); float* out = OUTP(F);
    LAS float* PR = (LAS float*)(F.lds); LAS float* XC = PR + 3328; LAS float* RQ = XC + 512; LAS float* RK = RQ + 256; LAS float* HQ = RK + 256; LAS float* HF = HQ + 256; LAS float* HK = HF + 256;
    LAS float* DTv = HK + 256; LAS float* PART = DTv + 16; LAS float* OO = PART + 6144; LAS float* SS = OO + 768; LAS float* GYL = SS + 16; LAS float* ZP = GYL + 256;
    const size_t row = (size_t)MPROMPT + s;
    const bf16* PJ = (const bf16*)(ws + WS_PROJ) + row * NPROJ; bf16* MX = (bf16*)(ws + WS_MIXED) + row * DM;
    const int k = tid >> 3, vo = tid & 7;
    __syncthreads();
    f32x4 h0[12][2];
#pragma unroll
    for (int hid = 0; hid < 12; ++hid) { const float* hp = INP(F, hid < 4 ? 2 : hid < 8 ? 3 : 6) + (size_t)((l * MSAMP + s) * 4 + (hid & 3)) * 4096 + k * 64 + 8 * vo;
        h0[hid][0] = *(const f32x4*)hp; h0[hid][1] = *(const f32x4*)(hp + 4); }
    if (tid < 416) { const v4u x = *(const v4u*)(PJ + 8 * tid);
#pragma unroll
        for (int e = 0; e < 4; ++e) { PR[8 * tid + 2 * e] = __uint_as_float(x[e] << 16); PR[8 * tid + 2 * e + 1] = __uint_as_float(x[e] & 0xffff0000u); } }
    const float* cb0 = INP(F, 7) + (size_t)(l * MSAMP + s) * 1536;
    const float b0 = cb0[tid], b1 = cb0[512 + tid], b2 = cb0[1024 + tid];
    __syncthreads();
    { const float* cw = INP(F, 23) + l * 2048; const float x = PR[2816 + tid];
      XC[tid] = silu(INP(F, 24)[l * 512 + tid] + cw[tid] * b0 + cw[512 + tid] * b1 + cw[1024 + tid] * b2 + cw[1536 + tid] * x);
      float* cbo = out + O_SCONV + (size_t)(l * MSAMP + s) * 1536; cbo[tid] = b1; cbo[512 + tid] = b2; cbo[1024 + tid] = x; }
    if (tid < 4) DTv[tid] = softplus(((const float*)(ws + WS_DT))[row * 4 + tid] + INP(F, 25)[l * 4 + tid]);
    { const int which = tid >> 8, e = tid & 255, h = e >> 6, ch = e & 63, i = ch & 31;
      const float cs = ((const float*)(ws + WS_ROTC))[2048 * 32 + i], sn = ((const float*)(ws + WS_ROTS))[2048 * 32 + i];
      const float x1 = PR[which * 256 + h * 64 + i], x2 = PR[which * 256 + h * 64 + 32 + i];
      const float rv = ch < 32 ? x1 * cs - x2 * sn : x1 * sn + x2 * cs;
      if (which == 0) RQ[e] = rv; else RK[e] = rv * 0.125f; }
    if (tid < 256) { const float fr = PR[1280 + tid], lb = ((const float*)(ws + WS_LB))[l * 256 + tid]; HQ[tid] = silu(PR[1024 + tid]); HF[tid] = lb + (1.f - lb) * sigm(fr); HK[tid] = (1.f - lb) * sigm(-fr); }
    __syncthreads();
#pragma unroll
    for (int hid = 0; hid < 12; ++hid) { const int br = hid >> 2, h = hid & 3;
        float a, kk, q; f32x4 v0, v1;
        if (br == 0) { a = 1.f - 1.f / (float)(32 << h); kk = RK[h * 64 + k]; q = RQ[h * 64 + k]; v0 = *(LAS f32x4*)(PR + 512 + h * 64 + 8 * vo); v1 = *(LAS f32x4*)(PR + 512 + h * 64 + 8 * vo + 4); }
        else if (br == 1) { a = HF[h * 64 + k]; kk = HK[h * 64 + k]; q = HQ[h * 64 + k]; v0 = *(LAS f32x4*)(PR + 1536 + h * 64 + 8 * vo); v1 = *(LAS f32x4*)(PR + 1536 + h * 64 + 8 * vo + 4); }
        else { const float dt = DTv[h]; a = fexp(dt * (-fexp(INP(F, 26)[l * 4 + h]))); kk = XC[256 + (h >> 1) * 64 + k]; q = XC[384 + (h >> 1) * 64 + k]; v0 = *(LAS f32x4*)(XC + h * 64 + 8 * vo) * dt; v1 = *(LAS f32x4*)(XC + h * 64 + 8 * vo + 4) * dt; }
        const f32x4 n0 = h0[hid][0] * a + v0 * kk, n1 = h0[hid][1] * a + v1 * kk;
        float* ho = out + (br == 0 ? O_SRET : br == 1 ? O_SHGRN : O_SM2) + (size_t)((l * MSAMP + s) * 4 + h) * 4096 + k * 64 + 8 * vo;
        *(f32x4*)ho = n0; *(f32x4*)(ho + 4) = n1;
        float p[8] = {n0[0] * q, n0[1] * q, n0[2] * q, n0[3] * q, n1[0] * q, n1[1] * q, n1[2] * q, n1[3] * q};
#pragma unroll
        for (int j = 0; j < 8; ++j) { p[j] += __shfl_xor(p[j], 8); p[j] += __shfl_xor(p[j], 16); p[j] += __shfl_xor(p[j], 32); }
        if (lane < 8) {
#pragma unroll
            for (int j = 0; j < 8; ++j) PART[(hid * 8 + wv) * 64 + 8 * lane + j] = p[j]; }
    }
#pragma unroll
    for (int rnd = 0; rnd < 2; ++rnd) { const int g = 8 * rnd + wv, p = lane; const size_t ix = (size_t)((l * 16 + g) * 64 + p);
        const float* AB = (const float*)(ws + WS_S5AB); const float* BB = (const float*)(ws + WS_S5BB);
        const size_t so = (size_t)((l * MSAMP + s) * 16 + g) * 64 + p;
        const float h0r = INP(F, 4)[so], h0i = INP(F, 5)[so], ar = AB[2 * ix], ai = AB[2 * ix + 1];
        float br_ = 0.f, bi_ = 0.f;
#pragma unroll
        for (int c4 = 0; c4 < 8; ++c4) { const f32x4 b4 = *(const f32x4*)(BB + (ix * 16 + 2 * c4) * 2); const float u0 = PR[2048 + g * 16 + 2 * c4], u1 = PR[2048 + g * 16 + 2 * c4 + 1]; br_ += b4[0] * u0 + b4[2] * u1; bi_ += b4[1] * u0 + b4[3] * u1; }
        const float hr = ar * h0r - ai * h0i + br_, hi = ar * h0i + ai * h0r + bi_;
        out[O_SS5R + so] = hr; out[O_SS5I + so] = hi;
        const float* Cr = INP(F, 18) + (size_t)(l * 16 + g) * 1024; const float* Ci = INP(F, 19) + (size_t)(l * 16 + g) * 1024;
#pragma unroll 4
        for (int c = 0; c < 16; ++c) { const float y = wave_sum(Cr[c * 64 + p] * hr - Ci[c * 64 + p] * hi);
            if (lane == 0) GYL[g * 16 + c] = gelu_tanh(y + INP(F, 20)[l * 256 + g * 16 + c] * PR[2048 + g * 16 + c]); }
    }
    __syncthreads();
    float myv[2] = {0.f, 0.f};
#pragma unroll
    for (int rnd = 0; rnd < 2; ++rnd) { const int e = tid + 512 * rnd; if (e < 768) { const int hid = e >> 6, v = e & 63, br = hid >> 2, h = hid & 3;
        float o = 0.f;
#pragma unroll
        for (int w = 0; w < 8; ++w) o += PART[(hid * 8 + w) * 64 + v];
        if (br == 2) { o = (o + INP(F, 27)[l * 4 + h] * XC[h * 64 + v]) * silu(PR[2560 + h * 64 + v]); myv[rnd] = o; const float ss = wave_sum(o * o); if (lane == 0) SS[h] = ss; }
        else { const float rs = 1.f / sqrtf(wave_sum(o * o) * (1.f / 64.f) + EPS);
            MX[br * 256 + h * 64 + v] = (bf16)f2bf(o * rs * INP(F, br == 0 ? 10 : 12)[l * 256 + h * 64 + v] * silu(PR[(br == 0 ? 768 : 1792) + h * 64 + v])); } } }
    { const int n = tid & 255, kh = tid >> 8; const bf16* wr = (const bf16*)(ws + WS_WGLUT) + (size_t)l * 65536 + (size_t)n * 256 + 128 * kh;
      v4u wq[16];
#pragma unroll
      for (int j = 0; j < 16; ++j) wq[j] = *(const v4u*)(wr + 8 * j);
      float z = 0.f;
#pragma unroll
      for (int j = 0; j < 16; ++j)
#pragma unroll
          for (int e = 0; e < 4; ++e) { z += __uint_as_float(wq[j][e] << 16) * GYL[128 * kh + 8 * j + 2 * e] + __uint_as_float(wq[j][e] & 0xffff0000u) * GYL[128 * kh + 8 * j + 2 * e + 1]; }
      ZP[tid] = z; }
    __syncthreads();
    if (tid < 256) { const float z = ZP[tid] + ZP[256 + tid] + INP(F, 22)[l * 256 + tid];
        MX[512 + tid] = (bf16)f2bf(GYL[tid] * sigm(z) * silu(PR[2304 + tid])); }
    { const float rs = 1.f / sqrtf(((SS[0] + SS[1]) + (SS[2] + SS[3])) * (1.f / 256.f) + EPS);
#pragma unroll
      for (int rnd = 0; rnd < 2; ++rnd) { const int e = tid + 512 * rnd; if (e >= 512 && e < 768) { const int c = e - 512; MX[768 + c] = (bf16)f2bf(myv[rnd] * rs * INP(F, 28)[l * 256 + c]); } } }
}
constexpr int CW_Q = 16384;
DI int next_unit(Frame& F, gu32* q) {
    volatile LAS unsigned* slot = F.MISC + 16;
    if (F.tid == 0) *slot = __hip_atomic_fetch_add(q, 1u, __ATOMIC_RELAXED, __HIP_MEMORY_SCOPE_AGENT);
    __syncthreads();
    return (int)__builtin_amdgcn_readfirstlane(*slot);
}
DI void mixers_m1(Frame& F, int l) {
    gu32* q = F.ctl + CW_Q + 64 * (2 * l);
    for (;;) { const int i = next_unit(F, q); if (i >= 256 + MSAMP) break;
        if (i < 64) lin_unit<1, false>(F, l, i);
        else if (i < 128) lin_unit<2, false>(F, l, i - 64);
        else if (i < 256) sample_unit(F, l, i - 128);
        else if (i < 320) lin_unit<0, false>(F, l, i - 256);
        else s5_mfma_unit<false>(F, l, i - 320); }
}
DI void mixers_m3(Frame& F, int l) {
    gu32* q = F.ctl + CW_Q + 64 * (2 * l + 1);
    for (;;) { const int i = next_unit(F, q); if (i >= 256) break; const int pm = i & 63;
        if (i < 64) s5_mfma_unit<true>(F, l, pm); else if (i < 128) lin_unit<2, true>(F, l, pm); else if (i < 192) lin_unit<1, true>(F, l, pm); else lin_unit<0, true>(F, l, pm); }
}
__global__ void __launch_bounds__(NTHR, 2) mk_fwd(Args args) {
    extern __shared__ __attribute__((aligned(16))) unsigned char lds[];
    Frame F;
    F.lds = (LAS unsigned char*)lds; F.MISC = (volatile LAS unsigned*)(F.lds + MISC_OFF);
    const int wave0 = __builtin_amdgcn_readfirstlane(threadIdx.x >> 6);
    F.tid = threadIdx.x; F.lane = F.tid & 63; F.wave = wave0; F.wave0 = wave0;
    F.G = gridDim.x; { const int bx = blockIdx.x; F.vcu = (F.G % 8 == 0) ? (bx % 8) * (F.G / 8) + bx / 8 : bx; }
    F.ka = (const float* const*)__builtin_amdgcn_kernarg_segment_ptr(); F.out_ = args.out; F.ws_ = args.ws; F.ctl = (gu32*)(args.ws + WS_CTL);
    for (int u = F.tid; u < (LDS_BYTES - LDSCTL_OFF) / 4; u += NTHR) ((LAS unsigned*)(F.lds + LDSCTL_OFF))[u] = 0u;
    __syncthreads();
    XcdBarrier bar; bar.bar = (unsigned*)(F.ctl + CW_BAR); bar.x = 0; bar.st = nullptr;
    if (MK_N_LAUNCHES == 1) bar = xcd_barrier_post((unsigned*)(F.ctl + CW_BAR), F.MISC + 8);
    const int lo = args.ph_lo, hi = args.ph_hi;
#ifdef PROBE_SUB
    bool probe_rep = false;
#endif
#pragma unroll 1
    for (int ph = lo; ph < hi; ++ph) {
        int tid; asm volatile("v_mbcnt_lo_u32_b32 %0, -1, 0\n\tv_mbcnt_hi_u32_b32 %0, -1, %0" : "=v"(tid)); tid += wave0 * 64;
        F.tid = tid; F.lane = tid & 63; F.wave = __builtin_amdgcn_readfirstlane(tid >> 6);
        { int bx = blockIdx.x, G = gridDim.x; asm volatile("" : "+s"(bx), "+s"(G)); F.bx = bx; F.G = G; F.vcu = (G % 8 == 0) ? (bx % 8) * (G / 8) + bx / 8 : bx; }
        const int l = ph >= 6 ? 1 : 0, sub = ph == 0 ? -1 : ph - 1 - 5 * l;
        if (ph == 0) { prologue(F); }
        else if (sub == 0) {
            unsigned char* ws = WSP(F); bf16* XB = (bf16*)(ws + WS_XB); bf16* PROJ = (bf16*)(ws + WS_PROJ);
            pg8::Gemm g{XB, (const bf16*)(ws + WS_WINT) + (size_t)l * NPROJ * DM, MPAD, NPROJ, DM}; pg8::StaticOrder S; S.init(MPAD, NPROJ, F.G, F.bx);
            pg8::EpiBf16<0> E{PROJ, NPROJ, nullptr, 0, 0, 1.f};
#ifndef X_NOGEMM
            pg8::gemm_phase<pg8::EpiBf16<0>, pg8::StaticOrder, true, true>(F.lds + RING_OFF, g, S, E, tid);
#endif
        } else if (sub == 1) { mixers_m1(F, l); }
        else if (sub == 2) { mixers_m3(F, l); }
        else if (sub == 3) {
            unsigned char* ws = WSP(F); bf16* MX = (bf16*)(ws + WS_MIXED);
            pg8::Gemm g{MX, (const bf16*)(ws + WS_WOUTT) + (size_t)l * DM * DM, MPAD, DM, DM}; pg8::StaticOrder S; S.init(MPAD, DM, F.G, F.bx);
            pg8::EpiResid E{INP(F, 0), INP(F, 1), OUTP(F), l == 0 ? 1 : 0};
#ifndef X_NOGEMM
            pg8::gemm_phase<pg8::EpiResid, pg8::StaticOrder, true, true>(F.lds + RING_OFF, g, S, E, tid);
#endif
        } else { if (l == 0) aprep(F, 1); else final_norm(F); }
#ifdef PROBE_SUB
        const bool again = (sub == PROBE_SUB) && !probe_rep;
        if (again || ph + 1 < hi) xcd_barrier(bar);
        if (again) { probe_rep = true; --ph; } else probe_rep = false;
#else
        if (ph + 1 < hi) xcd_barrier(bar);
#endif
    }
}

extern "C" void kernel_launch(void* const* d_in, const int* in_sizes, int n_in, void* d_out, int out_size, void* d_ws, size_t ws_size, hipStream_t stream) {
    static int grid = 0;
    if (grid == 0) {
        if (n_in != 31 || out_size != (int)O_TOTAL || ws_size < WS_END) { fprintf(stderr, "kernel_launch: unexpected shapes: n_in %d out %d ws %zu\n", n_in, out_size, ws_size); grid = -1; return; }
        int dev = 0, cus = 0, per_cu = 0;
        if (hipGetDevice(&dev) != hipSuccess || hipDeviceGetAttribute(&cus, hipDeviceAttributeMultiprocessorCount, dev) != hipSuccess) { grid = -1; return; }
        if (hipFuncSetAttribute((const void*)mk_fwd, hipFuncAttributeMaxDynamicSharedMemorySize, LDS_BYTES) != hipSuccess) { fprintf(stderr, "kernel_launch: hipFuncSetAttribute failed\n"); grid = -1; return; }
        if (hipOccupancyMaxActiveBlocksPerMultiprocessor(&per_cu, (const void*)mk_fwd, NTHR, LDS_BYTES) != hipSuccess || per_cu < 1) { fprintf(stderr, "kernel_launch: occupancy query says %d\n", per_cu); per_cu = 1; }
        (void)hipGetLastError();
        grid = cus;
    }
    if (grid < 0) return;
    (void)hipMemsetAsync((char*)d_ws + WS_CTL, 0, CTL_ZERO_BYTES, stream);
    Args a{};
    for (int i = 0; i < 31; ++i) a.in[i] = (const float*)d_in[i];
    a.out = (float*)d_out; a.ws = (unsigned char*)d_ws;
    if (MK_N_LAUNCHES == 1) { a.ph_lo = 0; a.ph_hi = N_PHASES; a.li = 0; hipLaunchKernelGGL(mk_fwd, dim3(grid), dim3(NTHR), LDS_BYTES, stream, a); }
    else for (int p = 0; p < N_PHASES; ++p) { a.ph_lo = p; a.ph_hi = p + 1; a.li = p; hipLaunchKernelGGL(mk_fwd, dim3(grid), dim3(NTHR), LDS_BYTES, stream, a); }
}
```
